# Optimizing an MI355X kernel written in HIP

```python
import math
import jax
import jax.numpy as jnp
from jax import lax
import numpy as np

D_MODEL = 1024
BATCH = 1
SEQ = 16384
DEPTH = 2
DEC_BATCH = 32
DEC_SEQ = 1
PAST_LEN = 16384
PAGE_SIZE = 128

MIX = D_MODEL
W_A = MIX // 4
H_A = 4
HB_A = W_A // H_A
CONV_W = 4
LRU_C = 8.0
W_B = MIX // 4
H_B = 4
HD_B = W_B // H_B
PATTERNS = ((128, 1), (512, 4), (2048, 16))
WIN_MAX = 2048
Q_BLOCK = 128
N_BUCKETS = 32
MAX_EXACT = 16
NEG_INF = -1e30
W_C = MIX // 4
POOL_WINDOWS = (2, 4, 8, 16)
G_C = W_C // len(POOL_WINDOWS)
POOL_HIST = 15
W_D = MIX - W_A - W_B - W_C
H_D = 4
DV_D = W_D // H_D
DK_D = DV_D // 2
GLA_RANK = 16
GLA_TAU = 16.0
GLA_CHUNK = 64
D_FF = 4 * D_MODEL
EPS = 1e-6
IN_SIZES = (W_A, W_A, W_B, W_B, W_B, W_C, H_D * DK_D, H_D * DK_D, W_D, W_D, GLA_RANK)
N_IN = sum(IN_SIZES)

kernel_name = 'hymba_style_lru_dilated_pool_gla_decoder_step'


def _split_points():
    pts, acc = [], 0
    for s in IN_SIZES[:-1]:
        acc += s
        pts.append(acc)
    return pts


def _dilated_offsets():
    return np.concatenate([np.arange(w // d + 1) * d for w, d in PATTERNS]).astype(np.int32)


def _t5_bucket(dist):
    n = np.maximum(dist, 1).astype(np.float32)
    large = MAX_EXACT + (np.log(n / MAX_EXACT) / np.log(WIN_MAX / MAX_EXACT)
                         * (N_BUCKETS - MAX_EXACT)).astype(np.int32)
    large = np.minimum(np.maximum(large, MAX_EXACT), N_BUCKETS - 1)
    return np.where(dist < MAX_EXACT, dist, large).astype(np.int32)


def rmsnorm(x, g):
    xf = x.astype(jnp.float32)
    y = xf * lax.rsqrt(jnp.mean(xf * xf, axis=-1, keepdims=True) + EPS)
    return (y * g.astype(jnp.float32)).astype(x.dtype)


def causal_conv(u_hist, u, w, b):
    T = u.shape[1]
    ext = jnp.concatenate([u_hist.astype(u.dtype), u], axis=1)
    out = b + w[0] * ext[:, 0:T]
    for j in range(1, CONV_W):
        out = out + w[j] * ext[:, j:j + T]
    return out, ext[:, -(CONV_W - 1):]


def rg_lru(u, h0, wa, ba, wx, bx, lam):
    B, T, _ = u.shape
    ub = u.reshape(B, T, H_A, HB_A)
    r = jax.nn.sigmoid(jnp.einsum('bthi,hij->bthj', ub, wa).reshape(B, T, W_A) + ba).astype(jnp.float32)
    gi = jax.nn.sigmoid(jnp.einsum('bthi,hij->bthj', ub, wx).reshape(B, T, W_A) + bx).astype(jnp.float32)
    log_a = -LRU_C * jax.nn.softplus(-lam.astype(jnp.float32)) * r
    a = jnp.exp(log_a)
    inp = jnp.sqrt(-jnp.expm1(2.0 * log_a)) * (gi * u.astype(jnp.float32))

    def step(h, ab):
        a_t, b_t = ab
        h = a_t * h + b_t
        return h, h

    h_last, hs = lax.scan(step, h0.astype(jnp.float32), (jnp.moveaxis(a, 1, 0), jnp.moveaxis(inp, 1, 0)))
    return jnp.moveaxis(hs, 0, 1), h_last


def dilated_attend(q, k_span, v_span, q_idx, q_pos, bias):
    dist = jnp.asarray(_dilated_offsets())
    idx = q_idx[:, None] - dist[None, :]
    valid = (q_pos[:, None] - dist[None, :] >= 0) & (idx >= 0)
    idx = jnp.clip(idx, 0, k_span.shape[1] - 1)
    kg = jnp.take(k_span, idx, axis=1)
    vg = jnp.take(v_span, idx, axis=1)
    logits = jnp.einsum('bqhd,bqkhd->bhqk', q, kg).astype(jnp.float32) * (HD_B ** -0.5)
    logits = logits + bias[None, :, None, :]
    logits = jnp.where(valid[None, None], logits, NEG_INF)
    probs = jax.nn.softmax(logits, axis=-1).astype(v_span.dtype)
    return jnp.einsum('bhqk,bqkhd->bqhd', probs, vg)


def dilated_attn_prompt(q, k, v, bias):
    B, T, H, hd = q.shape
    pad = jnp.zeros((B, WIN_MAX, H, hd), k.dtype)
    k_pad = jnp.concatenate([pad, k], axis=1)
    v_pad = jnp.concatenate([pad, v], axis=1)
    span = WIN_MAX + Q_BLOCK
    q_idx = WIN_MAX + jnp.arange(Q_BLOCK)

    def block(i):
        s = i * Q_BLOCK
        qb = lax.dynamic_slice_in_dim(q, s, Q_BLOCK, axis=1)
        kb = lax.dynamic_slice_in_dim(k_pad, s, span, axis=1)
        vb = lax.dynamic_slice_in_dim(v_pad, s, span, axis=1)
        return dilated_attend(qb, kb, vb, q_idx, s + jnp.arange(Q_BLOCK), bias)

    out = lax.map(block, jnp.arange(T // Q_BLOCK))
    return jnp.moveaxis(out, 0, 1).reshape(B, T, H, hd)


def dilated_attn_cached(q, k, v, k_buf, v_buf, pos0, bias):
    L = k_buf.shape[1]
    T = q.shape[1]
    k_all = jnp.concatenate([k_buf.astype(k.dtype), k], axis=1)
    v_all = jnp.concatenate([v_buf.astype(v.dtype), v], axis=1)
    return dilated_attend(q, k_all, v_all, L + jnp.arange(T), pos0 + jnp.arange(T), bias)


def pool_mix(u_hist, u, pos0, w_pool, scale):
    B, T, W = u.shape
    ext = jnp.concatenate([u_hist.astype(u.dtype), u], axis=1)
    c = jnp.cumsum(ext.astype(jnp.float32), axis=1)
    c = jnp.concatenate([jnp.zeros((B, 1, W), jnp.float32), c], axis=1)
    end = c[:, POOL_HIST + 1:]
    pos = (pos0 + jnp.arange(T)).astype(jnp.float32)
    means = []
    for g, w in enumerate(POOL_WINDOWS):
        sl = slice(g * G_C, (g + 1) * G_C)
        start = c[:, POOL_HIST + 1 - w:POOL_HIST + 1 - w + T, sl]
        cnt = jnp.minimum(float(w), pos + 1.0)[None, :, None]
        means.append((end[..., sl] - start) / cnt)
    pooled = jnp.concatenate(means, axis=-1) - u.astype(jnp.float32)
    y = jnp.einsum('btgc,gcd->btgd', pooled.reshape(B, T, len(POOL_WINDOWS), G_C),
                   w_pool.astype(jnp.float32)).reshape(B, T, W) * scale.astype(jnp.float32)
    return y.astype(u.dtype), ext[:, -POOL_HIST:]


def gla_recurrent(q, k, v, g, s0, chunk):
    B, T, H, DK = q.shape
    n = T // chunk

    def to_chunks(t):
        return jnp.moveaxis(t.reshape(B, n, chunk, H, t.shape[-1]), 1, 0)

    mask = jnp.tril(jnp.ones((chunk, chunk), dtype=bool))

    def step(S, inp):
        qc, kc, vc, gc = inp
        b = jnp.cumsum(gc, axis=1)
        qb = qc * jnp.exp(b)
        kb = kc * jnp.exp(-b)
        att = jnp.where(mask, jnp.einsum('bihd,bjhd->bhij', qb, kb), 0.0)
        o = jnp.einsum('bhij,bjhv->bihv', att, vc) + jnp.einsum('bihd,bhdv->bihv', qb, S)
        bl = b[:, -1]
        S = jnp.exp(bl)[..., None] * S + jnp.einsum('bjhd,bjhv->bhdv', kc * jnp.exp(bl[:, None] - b), vc)
        return S, o

    S, o = lax.scan(step, s0, (to_chunks(q), to_chunks(k), to_chunks(v), to_chunks(g)))
    return jnp.moveaxis(o, 0, 1).reshape(B, T, H, v.shape[-1]), S


def trunk_layer(x, pos0, lru_h0, conv_hist, pool_hist, gla_s0, attn_fn, p):
    B, T, _ = x.shape
    dt = x.dtype
    h = rmsnorm(x, p['norm_pre_mix'])
    z = h @ p['w_in']
    a_u, a_g, b_q, b_k, b_v, c_u, d_q, d_k, d_v, d_r, d_lr = jnp.split(z, _split_points(), axis=-1)

    u, conv_new = causal_conv(conv_hist, a_u, p['conv_w'], p['conv_b'])
    hs, h_new = rg_lru(u, lru_h0, p['lru_wa'], p['lru_ba'], p['lru_wx'], p['lru_bx'], p['lru_lambda'])
    y_a = (hs * jax.nn.gelu(a_g.astype(jnp.float32))).astype(dt)

    k_b = b_k.reshape(B, T, H_B, HD_B)
    v_b = b_v.reshape(B, T, H_B, HD_B)
    y_b = attn_fn(b_q.reshape(B, T, H_B, HD_B), k_b, v_b).reshape(B, T, W_B).astype(dt)

    y_c, pool_new = pool_mix(pool_hist, c_u, pos0, p['pool_w'], p['pool_scale'])

    qd = d_q.astype(jnp.float32).reshape(B, T, H_D, DK_D) * (DK_D ** -0.5)
    kd = d_k.astype(jnp.float32).reshape(B, T, H_D, DK_D)
    vd = d_v.astype(jnp.float32).reshape(B, T, H_D, DV_D)
    gd = (jax.nn.log_sigmoid((d_lr @ p['gla_w_lr'] + p['gla_b']).astype(jnp.float32)) / GLA_TAU)
    gd = gd.reshape(B, T, H_D, DK_D)
    od, s_new = gla_recurrent(qd, kd, vd, gd, gla_s0.astype(jnp.float32), math.gcd(T, GLA_CHUNK))
    od = od * lax.rsqrt(jnp.mean(od * od, axis=-1, keepdims=True) + EPS)
    y_d = (od.reshape(B, T, W_D) * p['gla_norm'].astype(jnp.float32)
           * jax.nn.silu(d_r.astype(jnp.float32))).astype(dt)

    mix = jnp.concatenate([y_a, y_b, y_c, y_d], axis=-1) @ p['w_out']
    x = x + rmsnorm(mix, p['norm_post_mix'])
    hm = rmsnorm(x, p['norm_pre_mlp'])
    m = jnp.square(jax.nn.relu(hm @ p['w_up'])) @ p['w_down']
    x = x + rmsnorm(m, p['norm_post_mlp'])
    return x, (h_new, conv_new, k_b, v_b, pool_new, s_new)


def setup_inputs(seed: int = 0) -> dict:
    key = jax.random.key(seed)
    ks = jax.random.split(key, 32)
    f32 = jnp.float32

    def nrm(k, shape, s):
        return s * jax.random.normal(k, shape, f32)

    L_s = min(WIN_MAX, PAST_LEN)
    a0 = jax.random.uniform(ks[30], (DEPTH, W_A), f32, 0.9, 0.999)
    sg = a0 ** (1.0 / LRU_C)
    lam = jnp.log(sg) - jnp.log1p(-sg)
    return {
        'x_prompt': nrm(ks[0], (BATCH, SEQ, D_MODEL), 1.0),
        'x_sample': nrm(ks[1], (DEC_BATCH, DEC_SEQ, D_MODEL), 1.0),
        'state_lru_h': nrm(ks[2], (DEPTH, DEC_BATCH, W_A), 0.5),
        'state_lru_conv': nrm(ks[3], (DEPTH, DEC_BATCH, CONV_W - 1, W_A), 1.0),
        'cache_win_k': nrm(ks[4], (DEPTH, DEC_BATCH, L_s, H_B, HD_B), 1.0),
        'cache_win_v': nrm(ks[5], (DEPTH, DEC_BATCH, L_s, H_B, HD_B), 1.0),
        'state_pool': nrm(ks[6], (DEPTH, DEC_BATCH, POOL_HIST, W_C), 1.0),
        'state_gla': nrm(ks[7], (DEPTH, DEC_BATCH, H_D, DK_D, DV_D), 0.5),
        'norm_pre_mix': 1.0 + nrm(ks[8], (DEPTH, D_MODEL), 0.02),
        'norm_post_mix': 1.0 + nrm(ks[9], (DEPTH, D_MODEL), 0.02),
        'norm_pre_mlp': 1.0 + nrm(ks[10], (DEPTH, D_MODEL), 0.02),
        'norm_post_mlp': 1.0 + nrm(ks[11], (DEPTH, D_MODEL), 0.02),
        'w_in': nrm(ks[12], (DEPTH, D_MODEL, N_IN), D_MODEL ** -0.5),
        'conv_w': nrm(ks[13], (DEPTH, CONV_W, W_A), CONV_W ** -0.5),
        'conv_b': nrm(ks[14], (DEPTH, W_A), 0.01),
        'lru_wa': nrm(ks[15], (DEPTH, H_A, HB_A, HB_A), HB_A ** -0.5),
        'lru_ba': nrm(ks[16], (DEPTH, W_A), 0.01),
        'lru_wx': nrm(ks[17], (DEPTH, H_A, HB_A, HB_A), HB_A ** -0.5),
        'lru_bx': nrm(ks[18], (DEPTH, W_A), 0.01),
        'lru_lambda': lam,
        'rel_bias': nrm(ks[19], (N_BUCKETS, H_B), 0.5),
        'pool_w': nrm(ks[20], (DEPTH, len(POOL_WINDOWS), G_C, G_C), G_C ** -0.5),
        'pool_scale': 1.0 + nrm(ks[21], (DEPTH, W_C), 0.02),
        'gla_w_lr': nrm(ks[22], (DEPTH, GLA_RANK, H_D * DK_D), GLA_RANK ** -0.5),
        'gla_b': nrm(ks[23], (DEPTH, H_D * DK_D), 0.01),
        'gla_norm': 1.0 + nrm(ks[24], (DEPTH, W_D), 0.02),
        'w_out': nrm(ks[25], (DEPTH, MIX, D_MODEL), MIX ** -0.5),
        'w_up': nrm(ks[26], (DEPTH, D_MODEL, D_FF), D_MODEL ** -0.5),
        'w_down': nrm(ks[27], (DEPTH, D_FF, D_MODEL), D_FF ** -0.5),
    }


def reference(x_prompt, x_sample, state_lru_h, state_lru_conv, cache_win_k, cache_win_v, state_pool,
              state_gla, norm_pre_mix, norm_post_mix, norm_pre_mlp, norm_post_mlp, w_in, conv_w, conv_b,
              lru_wa, lru_ba, lru_wx, lru_bx, lru_lambda, rel_bias, pool_w, pool_scale, gla_w_lr, gla_b,
              gla_norm, w_out, w_up, w_down):
    bucket = _t5_bucket(_dilated_offsets())
    bias = jnp.take(rel_bias.astype(jnp.float32), jnp.asarray(bucket), axis=0).T
    Bp, Tp = x_prompt.shape[0], x_prompt.shape[1]
    L_p = min(WIN_MAX, Tp)
    xp, xs = x_prompt, x_sample
    p_states, s_states = [], []
    for l in range(DEPTH):
        prm = {
            'norm_pre_mix': norm_pre_mix[l], 'norm_post_mix': norm_post_mix[l],
            'norm_pre_mlp': norm_pre_mlp[l], 'norm_post_mlp': norm_post_mlp[l],
            'w_in': w_in[l], 'conv_w': conv_w[l], 'conv_b': conv_b[l],
            'lru_wa': lru_wa[l], 'lru_ba': lru_ba[l], 'lru_wx': lru_wx[l], 'lru_bx': lru_bx[l],
            'lru_lambda': lru_lambda[l], 'pool_w': pool_w[l], 'pool_scale': pool_scale[l],
            'gla_w_lr': gla_w_lr[l], 'gla_b': gla_b[l], 'gla_norm': gla_norm[l],
            'w_out': w_out[l], 'w_up': w_up[l], 'w_down': w_down[l],
        }
        xp, (ph, pc, pk, pv, pp, pg) = trunk_layer(
            xp, 0,
            jnp.zeros((Bp, W_A), state_lru_h.dtype),
            jnp.zeros((Bp, CONV_W - 1, W_A), xp.dtype),
            jnp.zeros((Bp, POOL_HIST, W_C), xp.dtype),
            jnp.zeros((Bp, H_D, DK_D, DV_D), state_gla.dtype),
            lambda q, k, v: dilated_attn_prompt(q, k, v, bias), prm)
        p_states.append((ph.astype(state_lru_h.dtype), pc, pk[:, -L_p:], pv[:, -L_p:], pp,
                         pg.astype(state_gla.dtype)))
        kc, vc = cache_win_k[l], cache_win_v[l]
        xs, (sh, sc, sk, sv, sp, sgs) = trunk_layer(
            xs, PAST_LEN, state_lru_h[l], state_lru_conv[l], state_pool[l], state_gla[l],
            lambda q, k, v, kc=kc, vc=vc: dilated_attn_cached(q, k, v, kc, vc, PAST_LEN, bias), prm)
        s_states.append((sh.astype(state_lru_h.dtype), sc, sk, sv, sp, sgs.astype(state_gla.dtype)))
    p_h, p_conv, p_k, p_v, p_pool, p_gla = (jnp.stack(z, axis=0) for z in zip(*p_states))
    s_h, s_conv, s_k, s_v, s_pool, s_gla = (jnp.stack(z, axis=0) for z in zip(*s_states))
    return (xp, xs, p_h, p_conv, p_k, p_v, p_pool, p_gla, s_h, s_conv, s_k, s_v, s_pool, s_gla)
```

```cpp
#include <hip/hip_runtime.h>
#include <hip/hip_cooperative_groups.h>
#include <cstdio>
#include <cstdint>
namespace cg = cooperative_groups;
namespace pg8 {
#define PG8_LAS __attribute__((address_space(3)))
typedef unsigned short bf16_t;
typedef short bf16x8 __attribute__((ext_vector_type(8)));
typedef float f32x4 __attribute__((ext_vector_type(4)));
typedef unsigned u32x4 __attribute__((ext_vector_type(4)));
constexpr int BM = 256, BK = 64, HALF = 128, HTB = HALF * BK * 2  , STAGE_BYTES = 8 * HTB, NXCD = 8, WGM = 8;

__host__ __device__ __forceinline__ int lds_byte(int r, int c) { const int st = (r >> 4) * 2 + (c >> 5), rr = r & 15, cc = c & 31, ob = rr * 64 + cc * 2; return st * 1024 + (ob ^ (((ob >> 9) & 1) << 5)); }
__host__ __device__ __forceinline__ void stage_rc(int b, int& R, int& C) { const int st = b / 1024, sb = b % 1024, swz = sb ^ (((sb >> 9) & 1) << 5); R = (st >> 1) * 16 + swz / 64; C = (st & 1) * 32 + (swz % 64) / 2; }
__host__ __device__ __forceinline__ int perm32(int rho) { const int n = rho >> 4, i = rho & 15; return 8 * (i >> 2) + 4 * n + (i & 3); }

struct Unit { int pm, pn; };
struct Gemm { const bf16_t* A; const bf16_t* Bt; int M, N, K; };

struct StaticOrder {
    int nM, nN, nwg, G, c;
    __host__ __device__ void init(int M, int N, int G_, int c_) { nM = M / BM; nN = N / BM; nwg = nM * nN; G = G_; c = c_; }
    __host__ __device__ bool next(int i, Unit& u) const {
        const long L = (long)i * G + c; if (L >= nwg) return false;
        int wgid = (int)L; { const int q = nwg / NXCD, r = nwg % NXCD, xcd = wgid % NXCD, off = wgid / NXCD; wgid = (xcd < r ? xcd * (q + 1) : r * (q + 1) + (xcd - r) * q) + off; }
        const int nig = WGM * nN, gid = wgid / nig, fm = gid * WGM, gsz = (nM - fm) < WGM ? (nM - fm) : WGM;
        u.pm = fm + ((wgid % nig) % gsz); u.pn = (wgid % nig) / gsz; return true;
    }
    __device__ __forceinline__ void a_ready(const Unit&) const {}
    __device__ __forceinline__ void done(const Unit&) const {}
};

__device__ __forceinline__ unsigned cvt_pk_bf16(float lo, float hi) { unsigned r; asm volatile("v_cvt_pk_bf16_f32 %0, %1, %2" : "=v"(r) : "v"(lo), "v"(hi)); return r; }
template <int ACT> struct EpiScaleBf16 {
    static constexpr bool PERM = true, AFTER_DRAIN = false;
    bf16_t* O; int ldc; const float* rscale;
    __device__ __forceinline__ void operator()(const f32x4 (&acc)[2][2][4][2], const Unit& u, int wr, int wc, int fr, int fq) const {
        const int row0 = u.pm * BM + wr * 64 + fr; const int col0 = u.pn * BM + wc * 32 + 8 * fq;
#pragma unroll
        for (int ai = 0; ai < 2; ++ai)
#pragma unroll
            for (int m = 0; m < 4; ++m) { const int row = row0 + ai * HALF + m * 16; const float sc = rscale[row]; bf16_t* rowp = O + (size_t)row * ldc + col0;
#pragma unroll
                for (int bj = 0; bj < 2; ++bj) { f32x4 v0 = acc[ai][bj][m][0] * sc, v1 = acc[ai][bj][m][1] * sc;
                    if (ACT == 1) {
#pragma unroll
                        for (int e = 0; e < 4; ++e) { const float a = fmaxf(v0[e], 0.f), b = fmaxf(v1[e], 0.f); v0[e] = a * a; v1[e] = b * b; } }
                    u32x4 w; w.x = cvt_pk_bf16(v0[0], v0[1]); w.y = cvt_pk_bf16(v0[2], v0[3]); w.z = cvt_pk_bf16(v1[0], v1[1]); w.w = cvt_pk_bf16(v1[2], v1[3]);
                    *(u32x4*)(rowp + bj * HALF) = w; } }
    }
};
struct EpiF32 {
    static constexpr bool PERM = true, AFTER_DRAIN = false;
    float* O; int ldc;
    __device__ __forceinline__ void operator()(const f32x4 (&acc)[2][2][4][2], const Unit& u, int wr, int wc, int fr, int fq) const {
        const int row0 = u.pm * BM + wr * 64 + fr; const int col0 = u.pn * BM + wc * 32 + 8 * fq;
#pragma unroll
        for (int ai = 0; ai < 2; ++ai)
#pragma unroll
            for (int m = 0; m < 4; ++m) { float* rowp = O + (size_t)(row0 + ai * HALF + m * 16) * ldc + col0;
#pragma unroll
                for (int bj = 0; bj < 2; ++bj) { *(f32x4*)(rowp + bj * HALF) = acc[ai][bj][m][0]; *(f32x4*)(rowp + bj * HALF + 4) = acc[ai][bj][m][1]; } }
    }
};

template <class Epi, class Sched, bool ALIGN_EPI = false, bool SP2 = false>
__device__ __forceinline__ void gemm_phase(PG8_LAS unsigned char* lds, const Gemm g, const Sched& S, const Epi& E) {
    int tid_l = threadIdx.x; asm volatile("" : "+v"(tid_l));
    const int tid = tid_l, wid = __builtin_amdgcn_readfirstlane(tid >> 6), lane = tid & 63, wr = wid >> 2, wc = wid & 3, fr = lane & 15, fq = lane >> 4;
    const int K = g.K, nt = K / BK;
    unsigned voffA, voffB;
    { int R, C; stage_rc(tid * 16, R, C); const int Rb = Epi::PERM ? ((R & ~31) + perm32(R & 31)) : R;
        voffA = (unsigned)(R * K + C) * 2u; voffB = (unsigned)(Rb * K + C) * 2u; }
    const size_t rstep = (size_t)64 * K * 2;
    const size_t kstep = (size_t)(BK * 2);
    const size_t hstep = (size_t)HALF * K * 2;
    const size_t tstep = 2 * hstep;
    const unsigned ldsw = (unsigned)wid * 1024u;
    const int aoff = lds_byte(wr * 64 + fr, fq * 8), boff = lds_byte(wc * 32 + fr, fq * 8);
#define PG8_SA(b, h) (((b) * 2 + (h)) * HTB)
#define PG8_SB(b, h) ((4 + (b) * 2 + (h)) * HTB)
#define PG8_STAGE(bufoff, gbase, voff) do { _Pragma("unroll") for (int _i = 0; _i < 2; ++_i) \
        __builtin_amdgcn_global_load_lds((const unsigned*)((const char*)(gbase) + (size_t)_i * rstep + (voff)), (PG8_LAS unsigned*)(lds + (bufoff) + ldsw + _i * 8192), 16, 0, 0); } while (0)
#define PG8_LDA(dst, b, h) do { _Pragma("unroll") for (int m = 0; m < 4; ++m) _Pragma("unroll") for (int k = 0; k < 2; ++k) dst[m][k] = *(const PG8_LAS bf16x8*)(lds + PG8_SA(b, h) + aoff + m * 2048 + k * 1024); } while (0)
#define PG8_LDB(dst, b, h) do { _Pragma("unroll") for (int n = 0; n < 2; ++n) _Pragma("unroll") for (int k = 0; k < 2; ++k) dst[n][k] = *(const PG8_LAS bf16x8*)(lds + PG8_SB(b, h) + boff + n * 2048 + k * 1024); } while (0)
#define PG8_MMA(ai, bj, At, Bt) do { __builtin_amdgcn_s_setprio(1); _Pragma("unroll") for (int m = 0; m < 4; ++m) _Pragma("unroll") for (int n = 0; n < 2; ++n) _Pragma("unroll") for (int k = 0; k < 2; ++k) \
        acc[ai][bj][m][n] = __builtin_amdgcn_mfma_f32_16x16x32_bf16(Bt[n][k], At[m][k], acc[ai][bj][m][n], 0, 0, 0); __builtin_amdgcn_s_setprio(0); } while (0)
#define PG8_WAIT_V(n) asm volatile("s_waitcnt vmcnt(" #n ")" ::: "memory")
#define PG8_WAIT_L(n) asm volatile("s_waitcnt lgkmcnt(" #n ")" ::: "memory")
#define PG8_BAR __builtin_amdgcn_s_barrier()
#define PG8_SCHED __builtin_amdgcn_sched_barrier(0)
    Unit cur, nxt; int ui = 0;
    if (!S.next(0, cur)) return;
    f32x4 acc[2][2][4][2];
#pragma unroll
    for (int a = 0; a < 2; ++a)
#pragma unroll
        for (int b = 0; b < 2; ++b)
#pragma unroll
            for (int m = 0; m < 4; ++m)
#pragma unroll
                for (int n = 0; n < 2; ++n) acc[a][b][m][n] = (f32x4){0.f, 0.f, 0.f, 0.f};
    bf16x8 At[4][2], B0[2][2], B1[2][2];
    const char* cA = (const char*)g.A + (size_t)cur.pm * tstep; const char* cB = (const char*)g.Bt + (size_t)cur.pn * tstep;
    S.a_ready(cur);
    if constexpr (SP2) {
        PG8_STAGE(PG8_SB(0, 0), cB, voffB); PG8_STAGE(PG8_SB(0, 1), cB + hstep, voffB); PG8_STAGE(PG8_SA(0, 0), cA, voffA); PG8_STAGE(PG8_SA(0, 1), cA + hstep, voffA);
        if (wr == 1) PG8_BAR;
        PG8_WAIT_V(2); PG8_BAR;
        PG8_STAGE(PG8_SB(1, 0), cB + kstep, voffB); PG8_STAGE(PG8_SA(1, 0), cA + kstep, voffA); PG8_STAGE(PG8_SB(1, 1), cB + hstep + kstep, voffB);
        PG8_WAIT_V(6); PG8_BAR;
    } else {
        PG8_STAGE(PG8_SB(0, 0), cB, voffB); PG8_STAGE(PG8_SA(0, 0), cA, voffA); PG8_STAGE(PG8_SB(0, 1), cB + hstep, voffB); PG8_STAGE(PG8_SA(0, 1), cA + hstep, voffA);
        if (wr == 1) PG8_BAR;
        PG8_WAIT_V(4); PG8_BAR;
        PG8_STAGE(PG8_SB(1, 0), cB + kstep, voffB); PG8_STAGE(PG8_SA(1, 0), cA + kstep, voffA); PG8_STAGE(PG8_SB(1, 1), cB + hstep + kstep, voffB);
        PG8_WAIT_V(6); PG8_BAR;
    }
    for (;;) {
        const bool has_next = S.next(ui + 1, nxt);
        const char* nA = has_next ? (const char*)g.A + (size_t)nxt.pm * tstep : cA; const char* nB = has_next ? (const char*)g.Bt + (size_t)nxt.pn * tstep : cB;
        for (int t = 0; t < nt; t += 2) {
            const bool last = (t == nt - 2);
            const char* a1 = cA + (size_t)(t + 1) * kstep;
            const char* a2 = last ? nA : cA + (size_t)(t + 2) * kstep; const char* b2 = last ? nB : cB + (size_t)(t + 2) * kstep;
            const char* a3 = a2 + kstep; const char* b3 = b2 + kstep;
            if (last && has_next) S.a_ready(nxt);
            if constexpr (SP2) {
            PG8_LDB(B0, 0, 0); PG8_LDB(B1, 0, 1); PG8_SCHED; PG8_LDA(At, 0, 0); PG8_STAGE(PG8_SA(1, 1), a1 + hstep, voffA);
            PG8_WAIT_V(8); PG8_WAIT_L(0); PG8_BAR; PG8_MMA(0, 0, At, B0); PG8_MMA(0, 1, At, B1); PG8_BAR; PG8_SCHED;
            PG8_LDA(At, 0, 1); PG8_STAGE(PG8_SB(0, 0), b2, voffB); PG8_STAGE(PG8_SB(0, 1), b2 + hstep, voffB); PG8_STAGE(PG8_SA(0, 0), a2, voffA);
            PG8_WAIT_V(8); PG8_WAIT_L(0); PG8_BAR; PG8_MMA(1, 0, At, B0); PG8_MMA(1, 1, At, B1); PG8_BAR; PG8_SCHED;
            PG8_LDB(B0, 1, 0); PG8_LDB(B1, 1, 1); PG8_SCHED; PG8_LDA(At, 1, 0); PG8_STAGE(PG8_SA(0, 1), a2 + hstep, voffA);
            PG8_WAIT_V(8); PG8_WAIT_L(0); PG8_BAR; PG8_MMA(0, 0, At, B0); PG8_MMA(0, 1, At, B1); PG8_BAR; PG8_SCHED;
            PG8_LDA(At, 1, 1); PG8_STAGE(PG8_SB(1, 0), b3, voffB); PG8_STAGE(PG8_SB(1, 1), b3 + hstep, voffB); PG8_STAGE(PG8_SA(1, 0), a3, voffA);
            PG8_WAIT_V(8); PG8_WAIT_L(0); PG8_BAR; PG8_MMA(1, 0, At, B0); PG8_MMA(1, 1, At, B1); PG8_BAR; PG8_SCHED;
            } else {
            PG8_LDB(B0, 0, 0); PG8_SCHED; PG8_LDA(At, 0, 0); PG8_STAGE(PG8_SA(1, 1), a1 + hstep, voffA);
            PG8_WAIT_L(8); PG8_BAR; PG8_WAIT_L(0); PG8_MMA(0, 0, At, B0); PG8_BAR; PG8_SCHED;
            PG8_LDB(B1, 0, 1); PG8_STAGE(PG8_SB(0, 0), b2, voffB);
            PG8_BAR; PG8_WAIT_L(0); PG8_MMA(0, 1, At, B1); PG8_BAR;
            PG8_LDA(At, 0, 1); PG8_STAGE(PG8_SA(0, 0), a2, voffA);
            PG8_BAR; PG8_WAIT_L(0); PG8_MMA(1, 0, At, B0); PG8_BAR; PG8_SCHED;
            PG8_STAGE(PG8_SB(0, 1), b2 + hstep, voffB);
            PG8_WAIT_V(6); PG8_BAR; PG8_MMA(1, 1, At, B1); PG8_BAR;
            PG8_LDB(B0, 1, 0); PG8_SCHED; PG8_LDA(At, 1, 0); PG8_STAGE(PG8_SA(0, 1), a2 + hstep, voffA);
            PG8_WAIT_L(8); PG8_BAR; PG8_WAIT_L(0); PG8_MMA(0, 0, At, B0); PG8_BAR; PG8_SCHED;
            PG8_LDB(B1, 1, 1); PG8_STAGE(PG8_SB(1, 0), b3, voffB);
            PG8_BAR; PG8_WAIT_L(0); PG8_MMA(0, 1, At, B1); PG8_BAR;
            PG8_LDA(At, 1, 1); PG8_STAGE(PG8_SA(1, 0), a3, voffA);
            PG8_BAR; PG8_WAIT_L(0); PG8_MMA(1, 0, At, B0); PG8_BAR; PG8_SCHED;
            PG8_STAGE(PG8_SB(1, 1), b3 + hstep, voffB);
            PG8_WAIT_V(6); PG8_BAR; PG8_MMA(1, 1, At, B1); PG8_BAR;
            }
        }
        if constexpr (ALIGN_EPI) { if (wr == 0) PG8_BAR; }
        if constexpr (!Epi::AFTER_DRAIN) { E(acc, cur, wr, wc, fr, fq); S.done(cur); }
        if (!has_next) break;
#pragma unroll
        for (int a = 0; a < 2; ++a)
#pragma unroll
            for (int b = 0; b < 2; ++b)
#pragma unroll
                for (int m = 0; m < 4; ++m)
#pragma unroll
                    for (int n = 0; n < 2; ++n) acc[a][b][m][n] = (f32x4){0.f, 0.f, 0.f, 0.f};
        cur = nxt; cA = nA; cB = nB; ++ui;
        if constexpr (ALIGN_EPI) { if (wr == 1) PG8_BAR; }
    }
    PG8_WAIT_V(0);
    if constexpr (!ALIGN_EPI) { if (wr == 0) PG8_BAR; }
    PG8_BAR;
    if constexpr (Epi::AFTER_DRAIN) { E.fused(acc, cur, wr, wc, fr, fq, lds, wid, lane); S.done(cur); }
#undef PG8_SA
#undef PG8_SB
#undef PG8_STAGE
#undef PG8_LDA
#undef PG8_LDB
#undef PG8_MMA
#undef PG8_WAIT_V
#undef PG8_WAIT_L
#undef PG8_BAR
#undef PG8_SCHED
}
}

#define GAS __attribute__((address_space(1)))
#define LAS __attribute__((address_space(3)))
typedef unsigned short bf16_t;
typedef float f32x4 __attribute__((ext_vector_type(4)));
typedef unsigned u32x4 __attribute__((ext_vector_type(4)));
typedef unsigned u32x2 __attribute__((ext_vector_type(2)));

constexpr int NT = 512, NWAVES = 8;
constexpr int DM = 1024, TP = 16384, NB = 32, MROWS = 16640, NROWS = TP + NB, NZ = 2304, NIN = 2320, FF = 4096;
constexpr float EPS = 1e-6f;
constexpr int C_AU = 0, C_AG = 256, C_BQ = 512, C_BK = 768, C_BV = 1024, C_CU = 1280, C_DQ = 1536, C_DK = 1664, C_DV = 1792, C_DR = 2048;
enum { I_XP = 0, I_XS, I_SLH, I_SLC, I_CK, I_CV, I_SPOOL, I_SGLA, I_NPREMIX, I_NPOSTMIX, I_NPREMLP, I_NPOSTMLP, I_WIN, I_CONVW, I_CONVB, I_WA, I_BA, I_WX, I_BX, I_LAM, I_RELB, I_POOLW, I_POOLS, I_WLR, I_GLAB, I_GLAN, I_WOUT, I_WUP, I_WDOWN, N_INPUTS };
constexpr size_t O_YP = 0, O_YS = O_YP + (size_t)TP * DM, O_PH = O_YS + NB * DM, O_PC = O_PH + 2 * 256, O_PK = O_PC + 2 * 3 * 256, O_PV = O_PK + 2 * 2048 * 256,
                 O_PP = O_PV + 2 * 2048 * 256, O_PG = O_PP + 2 * 15 * 256, O_SH = O_PG + 2 * 8192, O_SC = O_SH + 2 * NB * 256, O_SK = O_SC + 2 * NB * 3 * 256,
                 O_SV = O_SK + 2 * NB * 256, O_SP = O_SV + 2 * NB * 256, O_SG = O_SP + 2 * NB * 15 * 256, O_END = O_SG + 2 * NB * 8192;
static_assert(O_END == 19801600, "output size");
constexpr size_t MiB = 1u << 20;
constexpr size_t WS_CTL = 0, CTL_ZERO_BYTES = 1 * MiB;
constexpr size_t WS_WIN = 2 * MiB, WS_WOUT = 11 * MiB, WS_WUP = 15 * MiB, WS_WDN = 31 * MiB;
constexpr size_t WS_XB = 47 * MiB, WS_Z = 80 * MiB, WS_Y = 154 * MiB, WS_MIX = 187 * MiB, WS_U = 252 * MiB;
constexpr size_t WS_RSTD = 382 * MiB, WS_DLR = 383 * MiB, WS_HLOC = 385 * MiB, WS_PCUM = 401 * MiB, WS_LAGG = 417 * MiB;
constexpr size_t WS_GDS = 419 * MiB, WS_GDEC = 427 * MiB, WS_GB = 428 * MiB, WS_BIAS = 436 * MiB, WS_END = 437 * MiB;
constexpr int CW_BAR = 4096;
constexpr int LDS_BYTES = 147456, MISC_OFF = 131072 + 320;

__constant__ unsigned char BUCKET[387] = {
0,1,2,3,4,5,6,7,8,9,10,11,12,13,14,15,16,16,16,16,16,16,17,17,17,17,17,17,17,17,18,18,18,18,18,18,18,18,18,18,19,19,19,19,19,19,19,19,19,19,19,19,19,19,20,20,20,20,20,20,20,20,20,20,20,20,20,20,20,20,20,20,20,21,21,21,21,21,21,21,21,21,21,21,21,21,21,21,21,21,21,21,21,21,21,21,21,21,21,22,22,22,22,22,22,22,22,22,22,22,22,22,22,22,22,22,22,22,22,22,22,22,22,22,22,22,22,22,22,
0,4,8,12,16,16,17,17,18,18,19,19,19,19,20,20,20,20,20,21,21,21,21,21,21,22,22,22,22,22,22,22,22,22,23,23,23,23,23,23,23,23,23,23,23,23,24,24,24,24,24,24,24,24,24,24,24,24,24,24,24,24,25,25,25,25,25,25,25,25,25,25,25,25,25,25,25,25,25,25,25,25,25,26,26,26,26,26,26,26,26,26,26,26,26,26,26,26,26,26,26,26,26,26,26,26,26,26,26,26,26,26,26,27,27,27,27,27,27,27,27,27,27,27,27,27,27,27,27,
0,16,18,19,20,21,21,22,22,23,23,23,24,24,24,24,25,25,25,25,25,26,26,26,26,26,26,26,26,27,27,27,27,27,27,27,27,27,27,28,28,28,28,28,28,28,28,28,28,28,28,28,29,29,29,29,29,29,29,29,29,29,29,29,29,29,29,29,29,29,30,30,30,30,30,30,30,30,30,30,30,30,30,30,30,30,30,30,30,30,30,30,30,30,30,31,31,31,31,31,31,31,31,31,31,31,31,31,31,31,31,31,31,31,31,31,31,31,31,31,31,31,31,31,31,31,31,31,31};

#define XB_TMO      128
#define XB_XCNT(j)  (256  + 64 * (j))
#define XB_XSUB(j)  (1280 + 64 * (j))
#define XB_XGEN(j)  (2304 + 64 * (j))
#define XB_TOP      3328
#define XB_TOPGEN   3392
#define XCD_BAR_WORDS 3456
#define XB_SPIN_CAP (1u << 18)
__device__ __forceinline__ unsigned xb_ld(unsigned* p)              { return __hip_atomic_load(p, __ATOMIC_RELAXED, __HIP_MEMORY_SCOPE_AGENT); }
__device__ __forceinline__ unsigned xb_add(unsigned* p, unsigned v) { return __hip_atomic_fetch_add(p, v, __ATOMIC_RELAXED, __HIP_MEMORY_SCOPE_AGENT); }
__device__ __forceinline__ unsigned xb_xcc_id() { return (unsigned)__builtin_amdgcn_s_getreg((3 << 11) | 20) & 0xFu; }
#define XB_SPIN(cond, bar) do { unsigned _sp = 0; while (cond) { __builtin_amdgcn_s_sleep(1); \
    if ((++_sp & 255u) == 0u) { if (xb_ld(&(bar)[XB_TMO])) break; if (_sp > XB_SPIN_CAP) { atomicAdd(&(bar)[XB_TMO], 1u); break; } } } } while (0)
struct XcdBarrier { unsigned* bar; unsigned x; volatile LAS unsigned* st; };
__device__ __forceinline__ XcdBarrier xcd_barrier_post(unsigned* bar, volatile LAS unsigned* st) {
    XcdBarrier b; b.bar = bar; b.x = xb_xcc_id(); b.st = st;
    if (threadIdx.x == 0) (void)xb_add(&bar[XB_XCNT(b.x)], 1u);
    return b;
}
__device__ __forceinline__ void xcd_barrier_complete(unsigned* bar, unsigned x, unsigned& nloc, unsigned& nx) {
    const unsigned G = gridDim.x * gridDim.y * gridDim.z;
    unsigned sum, cnt, mine, sp = 0u;
    for (;;) {
        sum = 0u; cnt = 0u; mine = 0u;
#pragma unroll
        for (unsigned j = 0; j < 16; ++j) { const unsigned c = xb_ld(&bar[XB_XCNT(j)]); sum += c; cnt += (c > 0u) ? 1u : 0u; mine = (j == x) ? c : mine; }
        if (sum == G) break;
        __builtin_amdgcn_s_sleep(1);
        if ((++sp & 255u) == 0u) { if (xb_ld(&bar[XB_TMO])) break; if (sp > XB_SPIN_CAP) { atomicAdd(&bar[XB_TMO], 1u); break; } }
    }
    nloc = mine > 0u ? mine : 1u; nx = cnt > 0u ? cnt : 1u;
}
__device__ __forceinline__ void xcd_barrier(const XcdBarrier& b) {
    asm volatile("s_waitcnt vmcnt(0)" ::: "memory");
    __syncthreads();
    if (threadIdx.x == 0) {
        unsigned* bar = b.bar;
        __builtin_amdgcn_s_waitcnt(0);
        unsigned nloc = b.st[0], nx = b.st[1];
        if (nloc == 0u) { xcd_barrier_complete(bar, b.x, nloc, nx); b.st[0] = nloc; b.st[1] = nx; }
        const unsigned old = xb_add(&bar[XB_XSUB(b.x)], 1u);
        const unsigned gen = old / nloc;
        if (old + 1u == (gen + 1u) * nloc) {
            __builtin_amdgcn_fence(__ATOMIC_RELEASE, "agent");
            asm volatile("s_waitcnt vmcnt(0)" ::: "memory");
            const unsigned og = xb_add(&bar[XB_TOP], 1u);
            const unsigned tg = og / nx;
            if (og + 1u == (tg + 1u) * nx) xb_add(&bar[XB_TOPGEN], 1u);
            else XB_SPIN(xb_ld(&bar[XB_TOPGEN]) == tg, bar);
            __builtin_amdgcn_fence(__ATOMIC_ACQUIRE, "agent");
            xb_add(&bar[XB_XGEN(b.x)], 1u);
            asm volatile("s_waitcnt vmcnt(0)" ::: "memory");
        } else {
            XB_SPIN(xb_ld(&bar[XB_XGEN(b.x)]) == gen, bar);
            __builtin_amdgcn_fence(__ATOMIC_ACQUIRE, "agent");
            asm volatile("s_waitcnt vmcnt(0)" ::: "memory");
        }
    }
    __syncthreads();
}

#define LDS_WAIT() asm volatile("s_waitcnt lgkmcnt(0)" ::: "memory")
__device__ __forceinline__ float bf2f(bf16_t b) { return __uint_as_float((unsigned)b << 16); }
__device__ __forceinline__ float bflo(unsigned w) { return __uint_as_float(w << 16); }
__device__ __forceinline__ float bfhi(unsigned w) { return __uint_as_float(w & 0xffff0000u); }
__device__ __forceinline__ unsigned f2bf(float f) { unsigned u = __float_as_uint(f); return (u + 0x7fffu + ((u >> 16) & 1u)) >> 16; }
__device__ __forceinline__ unsigned pk2(float lo, float hi) { return f2bf(lo) | (f2bf(hi) << 16); }
__device__ __forceinline__ float wave_sum(float v) {
#pragma unroll
    for (int o = 1; o < 64; o <<= 1) v += __shfl_xor(v, o);
    return v;
}
__device__ __forceinline__ float wave_max(float v) {
#pragma unroll
    for (int o = 1; o < 64; o <<= 1) v = fmaxf(v, __shfl_xor(v, o));
    return v;
}
__device__ __forceinline__ float sigmoidf_(float x) { return 1.0f / (1.0f + __expf(-x)); }
__device__ __forceinline__ float logsigmoidf_(float x) { return fminf(x, 0.f) - log1pf(__expf(-fabsf(x))); }
__device__ __forceinline__ float gelu_tanh(float x) { const float u = 0.7978845608028654f * (x + 0.044715f * x * x * x); return 0.5f * x * (1.0f + tanhf(u)); }
__device__ __forceinline__ float siluf_(float x) { return x / (1.0f + __expf(-x)); }

struct Args { const float* in[N_INPUTS]; float* out; unsigned char* ws; };

__device__ __forceinline__ void p0_transpose_item(const float* W, int ldw, int K, int Ncols, const float* kscale, bf16_t* WT, LAS float* scr, int item, int lane) {
    const int nblk = Ncols / 32, kb = item / nblk, nb = item % nblk, k0 = 64 * kb, n0 = 32 * nb;
#pragma unroll 8
    for (int i = 0; i < 32; ++i) { const int kk = 2 * i + (lane >> 5); const float s = kscale ? kscale[k0 + kk] : 1.0f; scr[kk * 33 + (lane & 31)] = W[(size_t)(k0 + kk) * ldw + n0 + (lane & 31)] * s; }
    LDS_WAIT(); asm volatile("" ::: "memory");
    const int c = lane & 7;
#pragma unroll
    for (int j = 0; j < 4; ++j) { const int n = (lane >> 3) + 8 * j; const LAS float* s = scr + (8 * c) * 33 + n;
        u32x4 o; o.x = pk2(s[0 * 33], s[1 * 33]); o.y = pk2(s[2 * 33], s[3 * 33]); o.z = pk2(s[4 * 33], s[5 * 33]); o.w = pk2(s[6 * 33], s[7 * 33]);
        *(u32x4*)(WT + (size_t)(n0 + n) * K + k0 + 8 * c) = o; }
    LDS_WAIT(); asm volatile("" ::: "memory");
}

template <bool HAS_MIX, bool WANT_DLR>
__device__ __forceinline__ void rowpass(LAS unsigned char* lds, const float* xsrcP, const float* xsrcS, float* xdst, const float* mix, const float* gpost,
                                        const float* gpre_next, const float* win_next, bf16_t* XB, float* RSTD, float* DLR, int gw, int NGW, int tid) {
    const int lane = tid & 63;
    LAS float* WLT = (LAS float*)lds;
    if (WANT_DLR) {
        for (int idx = tid; idx < 16384; idx += NT) { const int k = idx >> 4, j = idx & 15; WLT[j * 1028 + k] = gpre_next[k] * win_next[(size_t)k * NIN + NZ + j]; }
        __syncthreads();
    }
    for (int row = gw; row < NROWS; row += NGW) {
        const float* xs = (row < TP) ? xsrcP + (size_t)row * DM : xsrcS + (size_t)(row - TP) * DM;
        f32x4 v[4];
#pragma unroll
        for (int j = 0; j < 4; ++j) v[j] = *(const f32x4*)(xs + 4 * lane + 256 * j);
        if (HAS_MIX) {
            f32x4 mv[4]; float s = 0.f;
#pragma unroll
            for (int j = 0; j < 4; ++j) { mv[j] = *(const f32x4*)(mix + (size_t)row * DM + 4 * lane + 256 * j); s += (mv[j].x * mv[j].x + mv[j].y * mv[j].y) + (mv[j].z * mv[j].z + mv[j].w * mv[j].w); }
            const float rm = rsqrtf(wave_sum(s) * (1.0f / DM) + EPS);
#pragma unroll
            for (int j = 0; j < 4; ++j) { const f32x4 g = *(const f32x4*)(gpost + 4 * lane + 256 * j); v[j] = v[j] + mv[j] * rm * g; }
        }
        if (xdst) {
#pragma unroll
            for (int j = 0; j < 4; ++j) *(f32x4*)(xdst + (size_t)row * DM + 4 * lane + 256 * j) = v[j];
        }
        float s2 = 0.f;
#pragma unroll
        for (int j = 0; j < 4; ++j) s2 += (v[j].x * v[j].x + v[j].y * v[j].y) + (v[j].z * v[j].z + v[j].w * v[j].w);
        const float rstd = rsqrtf(wave_sum(s2) * (1.0f / DM) + EPS);
        if (lane == 0) RSTD[row] = rstd;
#pragma unroll
        for (int j = 0; j < 4; ++j) { u32x2 w; w.x = pk2(v[j].x, v[j].y); w.y = pk2(v[j].z, v[j].w); *(u32x2*)(XB + (size_t)row * DM + 4 * lane + 256 * j) = w; }
        if (WANT_DLR) {
            float mine = 0.f; int lo = 4 * lane; asm volatile("" : "+v"(lo));
#pragma unroll
            for (int jj = 0; jj < 16; ++jj) {
                float a = 0.f;
#pragma unroll
                for (int j = 0; j < 4; ++j) { const f32x4 w = *(const LAS f32x4*)(WLT + jj * 1028 + lo + 256 * j); a += (v[j].x * w.x + v[j].y * w.y) + (v[j].z * w.z + v[j].w * w.w); }
                a = wave_sum(a);
                if ((lo >> 2) == jj) mine = a;
            }
            if (lane < 16) DLR[(size_t)row * 16 + lane] = mine * rstd;
        }
    }
    if (WANT_DLR) __syncthreads();
}

struct LayerP {
    const float *conv_w, *conv_b, *wa, *ba, *wx, *bx, *lam, *pool_w, *pool_s, *w_lr, *gla_b, *gla_n;
    const float *slh, *slc, *ck, *cv, *spool, *sgla;
    int l;
};
struct WsP { bf16_t *XB, *Z, *Y, *U; float *MIX, *RSTD, *DLR, *HLOC, *PCUM, *LA, *LH, *HIN, *GDS, *GDEC, *GB, *BIAS; };

constexpr int XS = 68;

__device__ __forceinline__ void lru_local(LAS unsigned char* lds, int tile, const LayerP& L, const WsP& W, float* out, int tid) {
    asm volatile("" : "+v"(tid));
    LAS float* XT = (LAS float*)lds;
    const int ch = tid & 255, half = tid >> 8, h = ch >> 6, j = ch & 63;
    const int t0 = tile * 64 + half * 32;
    const bf16_t* zc = W.Z + C_AU + ch;
    const float w0 = L.conv_w[ch], w1 = L.conv_w[256 + ch], w2 = L.conv_w[512 + ch], w3 = L.conv_w[768 + ch], cb = L.conv_b[ch];
    float am3 = (t0 >= 3) ? bf2f(zc[(size_t)(t0 - 3) * NZ]) : 0.f, am2 = (t0 >= 3) ? bf2f(zc[(size_t)(t0 - 2) * NZ]) : 0.f, am1 = (t0 >= 3) ? bf2f(zc[(size_t)(t0 - 1) * NZ]) : 0.f;
    float u[32];
#pragma unroll
    for (int tok = 0; tok < 32; ++tok) { const float a0 = bf2f(zc[(size_t)(t0 + tok) * NZ]); u[tok] = cb + w0 * am3 + w1 * am2 + w2 * am1 + w3 * a0; am3 = am2; am2 = am1; am1 = a0;
        XT[ch * XS + half * 32 + tok] = u[tok]; }
    if (tile == 255 && half == 1) { float* o = out + O_PC + (size_t)L.l * 768 + ch; o[0] = am3; o[256] = am2; o[512] = am1; }
    __syncthreads();
    float r[32], gi[32];
#pragma unroll
    for (int tok = 0; tok < 32; ++tok) { r[tok] = 0.f; gi[tok] = 0.f; }
    const float* wa = L.wa + h * 4096 + j; const float* wx = L.wx + h * 4096 + j;
    for (int i = 0; i < 64; ++i) {
        const float a_ = wa[i * 64], x_ = wx[i * 64];
        const LAS f32x4* xr = (const LAS f32x4*)(XT + (h * 64 + i) * XS + half * 32);
#pragma unroll
        for (int q = 0; q < 8; ++q) { const f32x4 xv = xr[q];
#pragma unroll
            for (int e = 0; e < 4; ++e) { r[4 * q + e] += xv[e] * a_; gi[4 * q + e] += xv[e] * x_; } }
    }
    const float ba = L.ba[ch], bx = L.bx[ch], c8 = -8.0f * log1pf(__expf(-L.lam[ch]));
    float P = 1.f, hl = 0.f;
#pragma unroll
    for (int tok = 0; tok < 32; ++tok) {
        const float rr = sigmoidf_(r[tok] + ba), gg = sigmoidf_(gi[tok] + bx), la = c8 * rr, a = __expf(la);
        const float inp = sqrtf(-expm1f(2.0f * la)) * (gg * u[tok]);
        hl = a * hl + inp; P *= a;
        W.HLOC[(size_t)(t0 + tok) * 256 + ch] = hl; W.PCUM[(size_t)(t0 + tok) * 256 + ch] = P;
    }
    const int seg = tile * 2 + half;
    W.LA[seg * 256 + ch] = P; W.LH[seg * 256 + ch] = hl;
    __syncthreads();
}

__device__ __forceinline__ void gla_local(LAS unsigned char* lds, int c, const LayerP& L, const WsP& W, int tid) {
    asm volatile("" : "+v"(tid));
    LAS float* Bc = (LAS float*)lds;
    LAS float* Kd = Bc + 8192;
    LAS float* Vs = Kd + 8192;
    const int t0 = c * 64;
    {
        const int n = tid & 127, q = tid >> 7;
        float wl[16];
#pragma unroll
        for (int jj = 0; jj < 16; ++jj) wl[jj] = L.w_lr[jj * 128 + n];
        const float gb = L.gla_b[n];
        for (int tt = 0; tt < 16; ++tt) { const int tok = q * 16 + tt; const float* d = W.DLR + (size_t)(t0 + tok) * 16; float a = gb;
#pragma unroll
            for (int jj = 0; jj < 16; ++jj) a += d[jj] * wl[jj];
            Bc[tok * 128 + n] = logsigmoidf_(a) * (1.0f / 16.0f); }
    }
    __syncthreads();
    if (tid < 128) { float s = 0.f; for (int tok = 0; tok < 64; ++tok) { s += Bc[tok * 128 + tid]; Bc[tok * 128 + tid] = s; W.GB[(size_t)(t0 + tok) * 128 + tid] = s; } }
    for (int idx = tid; idx < 64 * 16; idx += NT) { const int tok = idx >> 4, c8 = idx & 15; const u32x4 v = *(const u32x4*)(W.Z + (size_t)(t0 + tok) * NZ + C_DK + c8 * 8); LAS float* o = Kd + tok * 128 + c8 * 8;
        o[0] = bflo(v.x); o[1] = bfhi(v.x); o[2] = bflo(v.y); o[3] = bfhi(v.y); o[4] = bflo(v.z); o[5] = bfhi(v.z); o[6] = bflo(v.w); o[7] = bfhi(v.w); }
    for (int idx = tid; idx < 64 * 32; idx += NT) { const int tok = idx >> 5, c8 = idx & 31; const u32x4 v = *(const u32x4*)(W.Z + (size_t)(t0 + tok) * NZ + C_DV + c8 * 8); LAS float* o = Vs + tok * 256 + c8 * 8;
        o[0] = bflo(v.x); o[1] = bfhi(v.x); o[2] = bflo(v.y); o[3] = bfhi(v.y); o[4] = bflo(v.z); o[5] = bfhi(v.z); o[6] = bflo(v.w); o[7] = bfhi(v.w); }
    __syncthreads();
    for (int idx = tid; idx < 8192; idx += NT) { const int n = idx & 127; Kd[idx] *= __expf(Bc[63 * 128 + n] - Bc[idx]); }
    __syncthreads();
    {
        const int h = tid >> 7, dk = (tid & 127) >> 2, dv0 = (tid & 3) * 16;
        float acc[16];
#pragma unroll
        for (int e = 0; e < 16; ++e) acc[e] = 0.f;
        for (int jt = 0; jt < 64; ++jt) { const float kd = Kd[jt * 128 + h * 32 + dk]; const LAS f32x4* vp = (const LAS f32x4*)(Vs + jt * 256 + h * 64 + dv0);
#pragma unroll
            for (int q = 0; q < 4; ++q) { const f32x4 vv = vp[q];
#pragma unroll
                for (int e = 0; e < 4; ++e) acc[4 * q + e] += kd * vv[e]; } }
        float* o = W.GDS + ((size_t)(c * 4 + h) * 32 + dk) * 64 + dv0;
#pragma unroll
        for (int q = 0; q < 4; ++q) *(f32x4*)(o + 4 * q) = (f32x4){acc[4 * q], acc[4 * q + 1], acc[4 * q + 2], acc[4 * q + 3]};
        if ((tid & 3) == 0) W.GDEC[c * 128 + h * 32 + dk] = __expf(Bc[63 * 128 + h * 32 + dk]);
    }
    __syncthreads();
}

__device__ __forceinline__ void pool_tile(LAS unsigned char* lds, int tile, const LayerP& L, const WsP& W, float* out, int tid) {
    asm volatile("" : "+v"(tid));
    LAS float* PT = (LAS float*)lds;
    LAS bf16_t* CU = (LAS bf16_t*)(lds + 256 * XS * 4);
    const int t0 = tile * 64;
    for (int idx = tid; idx < 79 * 32; idx += NT) { const int r = idx >> 5, c8 = idx & 31; const int t = t0 - 15 + r;
        u32x4 v = (u32x4){0u, 0u, 0u, 0u}; if (t >= 0) v = *(const u32x4*)(W.Z + (size_t)t * NZ + C_CU + c8 * 8);
        *(LAS u32x4*)(CU + r * 256 + c8 * 8) = v; }
    __syncthreads();
    const int ch = tid & 255, half = tid >> 8, g = ch >> 6, w = 2 << g;
    if (tile == 255) { for (int r = 64 + half; r < 79; r += 2) out[O_PP + (size_t)L.l * 3840 + (r - 64) * 256 + ch] = bf2f(CU[r * 256 + ch]); }
    for (int tok = 0; tok < 32; ++tok) { const int tl = half * 32 + tok, t = t0 + tl; float s = 0.f;
        for (int i = 0; i < w; ++i) s += bf2f(CU[(15 + tl - i) * 256 + ch]);
        const float cnt = (float)((t + 1 < w) ? (t + 1) : w);
        PT[ch * XS + tl] = s / cnt - bf2f(CU[(15 + tl) * 256 + ch]); }
    __syncthreads();
    float acc[32];
#pragma unroll
    for (int tok = 0; tok < 32; ++tok) acc[tok] = 0.f;
    const float* wp = L.pool_w + g * 4096 + (ch & 63);
    for (int i = 0; i < 64; ++i) { const float w_ = wp[i * 64]; const LAS f32x4* xr = (const LAS f32x4*)(PT + (g * 64 + i) * XS + half * 32);
#pragma unroll
        for (int q = 0; q < 8; ++q) { const f32x4 xv = xr[q];
#pragma unroll
            for (int e = 0; e < 4; ++e) acc[4 * q + e] += xv[e] * w_; } }
    const float sc = L.pool_s[ch];
#pragma unroll
    for (int tok = 0; tok < 32; ++tok) W.Y[(size_t)(t0 + half * 32 + tok) * DM + 512 + ch] = (bf16_t)f2bf(acc[tok] * sc);
    __syncthreads();
}

__device__ __forceinline__ void unpack8(const u32x4 v, float* d) { d[0] = bflo(v.x); d[1] = bfhi(v.x); d[2] = bflo(v.y); d[3] = bfhi(v.y); d[4] = bflo(v.z); d[5] = bfhi(v.z); d[6] = bflo(v.w); d[7] = bfhi(v.w); }

__device__ __forceinline__ void attn_prompt_item(LAS float* PL, const WsP& W, int t, int h, int lane) {
    asm volatile("" : "+v"(lane));
    const int sg = lane >> 3, dg = lane & 7;
    float q[8]; unpack8(*(const u32x4*)(W.Z + (size_t)t * NZ + C_BQ + h * 64 + dg * 8), q);
    const bf16_t* kbase = W.Z + C_BK + h * 64 + dg * 8;
    const bf16_t* vbase = W.Z + C_BV + h * 64 + dg * 8;
    float m = -3.0e38f;
#pragma unroll 7
    for (int i = 0; i < 49; ++i) {
        const int s = i * 8 + sg; const int p = (s >= 258) ? 2 : ((s >= 129) ? 1 : 0); const int jj = s - 129 * p; const int ps = t - (jj << (2 * p));
        const bool valid = (s < 387) && (ps >= 0);
        float d = 0.f;
        if (valid) { float kk[8]; unpack8(*(const u32x4*)(kbase + (size_t)ps * NZ), kk);
#pragma unroll
            for (int e = 0; e < 8; ++e) d += q[e] * kk[e]; }
        d += __shfl_xor(d, 1); d += __shfl_xor(d, 2); d += __shfl_xor(d, 4);
        const float lg = valid ? d * 0.125f + W.BIAS[h * 388 + (valid ? s : 0)] : -1.0e30f;
        if (dg == 0) PL[s] = lg;
        m = fmaxf(m, lg);
    }
    m = wave_max(m);
    LDS_WAIT(); asm volatile("" ::: "memory");
    float sum = 0.f;
#pragma unroll
    for (int r = 0; r < 7; ++r) { const int s = r * 64 + lane; if (s < 392) { const float pr = __expf(PL[s] - m); PL[s] = pr; sum += pr; } }
    sum = wave_sum(sum);
    LDS_WAIT(); asm volatile("" ::: "memory");
    float o[8];
#pragma unroll
    for (int e = 0; e < 8; ++e) o[e] = 0.f;
#pragma unroll 7
    for (int i = 0; i < 49; ++i) {
        const int s = i * 8 + sg; const int p = (s >= 258) ? 2 : ((s >= 129) ? 1 : 0); const int jj = s - 129 * p; const int ps = t - (jj << (2 * p));
        const bool valid = (s < 387) && (ps >= 0);
        if (valid) { const float pr = PL[s]; float vv[8]; unpack8(*(const u32x4*)(vbase + (size_t)ps * NZ), vv);
#pragma unroll
            for (int e = 0; e < 8; ++e) o[e] += pr * vv[e]; }
    }
    const float inv = 1.0f / sum;
#pragma unroll
    for (int e = 0; e < 8; ++e) { float v = o[e]; v += __shfl_xor(v, 8); v += __shfl_xor(v, 16); v += __shfl_xor(v, 32); o[e] = v * inv; }
    if (sg == 0) { u32x4 w; w.x = pk2(o[0], o[1]); w.y = pk2(o[2], o[3]); w.z = pk2(o[4], o[5]); w.w = pk2(o[6], o[7]); *(u32x4*)(W.Y + (size_t)t * DM + 256 + h * 64 + dg * 8) = w; }
    LDS_WAIT(); asm volatile("" ::: "memory");
}
__device__ __forceinline__ void attn_sample_item(LAS float* SL, const LayerP& L, const WsP& W, int b, int h, int lane) {
    asm volatile("" : "+v"(lane));
    const size_t zrow = (size_t)(TP + b) * NZ;
    LAS float* QL = SL; LAS float* PL = SL + 64;
    QL[lane] = bf2f(W.Z[zrow + C_BQ + h * 64 + lane]);
    LDS_WAIT(); asm volatile("" ::: "memory");
    float m = -3.0e38f;
#pragma unroll 1
    for (int r = 0; r < 7; ++r) {
        const int s = r * 64 + lane; const int p = (s >= 258) ? 2 : ((s >= 129) ? 1 : 0); const int jj = s - 129 * p; const int dist = jj << (2 * p);
        const bool valid = (s < 387); const int idx = 2048 - dist;
        float d = 0.f;
        if (valid) {
            if (idx == 2048) { const bf16_t* kp = W.Z + zrow + C_BK + h * 64;
#pragma unroll 1
                for (int e = 0; e < 64; ++e) d += QL[e] * bf2f(kp[e]); }
            else { const f32x4* kp = (const f32x4*)(L.ck + ((size_t)b * 2048 + idx) * 256 + h * 64);
#pragma unroll 2
                for (int c = 0; c < 16; ++c) { const f32x4 kk = kp[c]; const f32x4 qq = *(const LAS f32x4*)(QL + 4 * c); d += (qq.x * kk.x + qq.y * kk.y) + (qq.z * kk.z + qq.w * kk.w); } }
        }
        const float lgv = valid ? d * 0.125f + W.BIAS[h * 388 + (valid ? s : 0)] : -1.0e30f;
        if (valid) PL[s] = lgv;
        m = fmaxf(m, lgv);
    }
    m = wave_max(m);
    float sum = 0.f;
#pragma unroll 1
    for (int r = 0; r < 7; ++r) { const int s = r * 64 + lane; if (s < 387) { const float pr = __expf(PL[s] - m); PL[s] = pr; sum += pr; } }
    sum = wave_sum(sum);
    LDS_WAIT(); asm volatile("" ::: "memory");
    float o = 0.f;
#pragma unroll 1
    for (int p = 0; p < 3; ++p) {
#pragma unroll 1
        for (int jj = 0; jj < 129; ++jj) { const int idx = 2048 - (jj << (2 * p)); const float pr = PL[p * 129 + jj];
            const float v = (idx == 2048) ? bf2f(W.Z[zrow + C_BV + h * 64 + lane]) : L.cv[((size_t)b * 2048 + idx) * 256 + h * 64 + lane];
            o += pr * v; }
    }
    W.Y[(size_t)(TP + b) * DM + 256 + h * 64 + lane] = (bf16_t)f2bf(o / sum);
    LDS_WAIT(); asm volatile("" ::: "memory");
}

__device__ __forceinline__ void sample_mixers(LAS unsigned char* lds, int b, const LayerP& L, const WsP& W, float* out, int tid) {
    asm volatile("" : "+v"(tid));
    LAS float* US = (LAS float*)lds;
    LAS float* PS = US + 256;
    LAS float* EG = PS + 256;
    LAS float* QS = EG + 128;
    LAS float* KS = QS + 128;
    LAS float* VV = KS + 128;
    LAS float* OP = VV + 256;
    const int row = TP + b, lb = b;
    const bf16_t* zr = W.Z + (size_t)row * NZ;
    const int l = L.l;
    if (tid < 256) {
        const int ch = tid;
        const float h0 = L.slc[((size_t)lb * 3 + 0) * 256 + ch], h1 = L.slc[((size_t)lb * 3 + 1) * 256 + ch], h2 = L.slc[((size_t)lb * 3 + 2) * 256 + ch], a0 = bf2f(zr[C_AU + ch]);
        US[ch] = L.conv_b[ch] + L.conv_w[ch] * h0 + L.conv_w[256 + ch] * h1 + L.conv_w[512 + ch] * h2 + L.conv_w[768 + ch] * a0;
        float* o = out + O_SC + ((size_t)(l * NB + b) * 3) * 256 + ch; o[0] = h1; o[256] = h2; o[512] = a0;
        out[O_SK + (size_t)(l * NB + b) * 256 + ch] = bf2f(zr[C_BK + ch]);
        out[O_SV + (size_t)(l * NB + b) * 256 + ch] = bf2f(zr[C_BV + ch]);
    } else {
        const int ch = tid - 256, g = ch >> 6, w = 2 << g;
        const float* hp = L.spool + (size_t)lb * 15 * 256 + ch; const float cu = bf2f(zr[C_CU + ch]);
        float s = cu;
#pragma unroll 1
        for (int i = 1; i < w; ++i) s += hp[(15 - i) * 256];
        PS[ch] = s / (float)w - cu;
        float* o = out + O_SP + (size_t)(l * NB + b) * 15 * 256 + ch;
#pragma unroll 2
        for (int r = 0; r < 14; ++r) o[r * 256] = hp[(r + 1) * 256];
        o[14 * 256] = cu;
    }
    if (tid < 128) {
        const int n = tid; float a = L.gla_b[n]; const float* d = W.DLR + (size_t)row * 16;
#pragma unroll
        for (int jj = 0; jj < 16; ++jj) a += d[jj] * L.w_lr[jj * 128 + n];
        EG[n] = __expf(logsigmoidf_(a) * (1.0f / 16.0f)); QS[n] = bf2f(zr[C_DQ + n]) * 0.17677669529663687f; KS[n] = bf2f(zr[C_DK + n]);
    } else if (tid < 384) { VV[tid - 128] = bf2f(zr[C_DV + tid - 128]); }
    __syncthreads();
    if (tid < 256) {
        const int ch = tid, h = ch >> 6, j = ch & 63; float r = 0.f, gi = 0.f;
#pragma unroll 4
        for (int i = 0; i < 64; ++i) { const float uu = US[h * 64 + i]; r += uu * L.wa[h * 4096 + i * 64 + j]; gi += uu * L.wx[h * 4096 + i * 64 + j]; }
        const float rr = sigmoidf_(r + L.ba[ch]), gg = sigmoidf_(gi + L.bx[ch]), la = -8.0f * log1pf(__expf(-L.lam[ch])) * rr, a = __expf(la);
        const float hn = a * L.slh[(size_t)lb * 256 + ch] + sqrtf(-expm1f(2.0f * la)) * (gg * US[ch]);
        out[O_SH + (size_t)(l * NB + b) * 256 + ch] = hn;
        W.Y[(size_t)row * DM + ch] = (bf16_t)f2bf(hn * gelu_tanh(bf2f(zr[C_AG + ch])));
    } else {
        const int d = tid - 256, g = d >> 6; float a = 0.f;
#pragma unroll 4
        for (int c = 0; c < 64; ++c) a += PS[g * 64 + c] * L.pool_w[g * 4096 + c * 64 + (d & 63)];
        W.Y[(size_t)row * DM + 512 + d] = (bf16_t)f2bf(a * L.pool_s[d]);
    }
    {
        const int dv = tid & 63, wv = tid >> 6;
        float po[4] = {0.f, 0.f, 0.f, 0.f};
#pragma unroll
        for (int k = 0; k < 16; ++k) { const int idx = tid + NT * k, hh = idx >> 11, dk = (idx >> 6) & 31;
            const float s0 = L.sgla[(size_t)lb * 8192 + idx]; const float sn = EG[hh * 32 + dk] * s0 + KS[hh * 32 + dk] * VV[hh * 64 + dv];
            out[O_SG + (size_t)(l * NB + b) * 8192 + idx] = sn; po[k >> 2] += QS[hh * 32 + dk] * sn; }
#pragma unroll
        for (int hh = 0; hh < 4; ++hh) OP[wv * 256 + hh * 64 + dv] = po[hh];
    }
    __syncthreads();
    if (tid < 256) {
        float o = 0.f;
#pragma unroll
        for (int wv = 0; wv < 8; ++wv) o += OP[wv * 256 + tid];
        const float ss = wave_sum(o * o);
        const float y = o * rsqrtf(ss * (1.0f / 64.0f) + EPS) * L.gla_n[tid] * siluf_(bf2f(zr[C_DR + tid]));
        W.Y[(size_t)row * DM + 768 + tid] = (bf16_t)f2bf(y);
    }
    { const int wv = tid >> 6; if (wv < 4) attn_sample_item((LAS float*)lds + 4096 + wv * 512, L, W, b, wv, tid & 63); }
    __syncthreads();
}

__device__ __forceinline__ void gla_scan_item(LAS unsigned char* lds, int it, const LayerP& L, const WsP& W, float* out, int tid) {
    asm volatile("" : "+v"(tid));
    LAS float* SA = (LAS float*)lds; LAS float* SS = SA + 16;
    const int h = it >> 6, dk = (it >> 1) & 31, dv0 = (it & 1) * 32, cgp = tid >> 5, e = tid & 31;
    float d[16], s[16];
#pragma unroll
    for (int i = 0; i < 16; ++i) { const int c = cgp * 16 + i; d[i] = W.GDEC[c * 128 + h * 32 + dk]; s[i] = W.GDS[((size_t)(c * 4 + h) * 32 + dk) * 64 + dv0 + e]; }
    float A = 1.f, S = 0.f;
#pragma unroll
    for (int i = 0; i < 16; ++i) { S = d[i] * S + s[i]; A *= d[i]; }
    if (e == 0) SA[cgp] = A;
    SS[cgp * 32 + e] = S;
    __syncthreads();
    float Sin = 0.f;
    for (int jg = 0; jg < cgp; ++jg) Sin = SA[jg] * Sin + SS[jg * 32 + e];
    S = Sin;
#pragma unroll
    for (int i = 0; i < 16; ++i) { const int c = cgp * 16 + i; W.GDS[((size_t)(c * 4 + h) * 32 + dk) * 64 + dv0 + e] = S; S = d[i] * S + s[i]; }
    if (cgp == 15) out[O_PG + (size_t)L.l * 8192 + (h * 32 + dk) * 64 + dv0 + e] = S;
    __syncthreads();
}
__device__ __forceinline__ void lru_scan_item(LAS unsigned char* lds, int it, const LayerP& L, const WsP& W, float* out, int tid) {
    asm volatile("" : "+v"(tid));
    LAS float* LA_ = (LAS float*)lds; LAS float* LH_ = LA_ + 512;
    const int e = tid & 15, sg = tid >> 4, ch = it * 16 + e;
    float a[16], hh[16];
#pragma unroll
    for (int i = 0; i < 16; ++i) { const int seg = sg * 16 + i; a[i] = W.LA[seg * 256 + ch]; hh[i] = W.LH[seg * 256 + ch]; }
    float A = 1.f, H = 0.f;
#pragma unroll
    for (int i = 0; i < 16; ++i) { H = a[i] * H + hh[i]; A *= a[i]; }
    LA_[sg * 16 + e] = A; LH_[sg * 16 + e] = H;
    __syncthreads();
    float Hin = 0.f;
    for (int jg = 0; jg < sg; ++jg) Hin = LA_[jg * 16 + e] * Hin + LH_[jg * 16 + e];
    H = Hin;
#pragma unroll
    for (int i = 0; i < 16; ++i) { const int seg = sg * 16 + i; W.HIN[seg * 256 + ch] = H; H = a[i] * H + hh[i]; }
    if (sg == 31) out[O_PH + (size_t)L.l * 256 + ch] = H;
    __syncthreads();
}

__device__ __forceinline__ void lru_final(int tile, const LayerP& L, const WsP& W, int tid) {
    asm volatile("" : "+v"(tid));
    const int ch = tid & 255, half = tid >> 8, seg = tile * 2 + half, t0 = tile * 64 + half * 32;
    const float hin = W.HIN[seg * 256 + ch];
#pragma unroll 4
    for (int tok = 0; tok < 32; ++tok) { const size_t t = (size_t)(t0 + tok);
        const float hv = W.HLOC[t * 256 + ch] + W.PCUM[t * 256 + ch] * hin;
        W.Y[t * DM + ch] = (bf16_t)f2bf(hv * gelu_tanh(bf2f(W.Z[t * NZ + C_AG + ch]))); }
}
__device__ __forceinline__ void gla_final(LAS unsigned char* lds, int c, const LayerP& L, const WsP& W, int tid) {
    asm volatile("" : "+v"(tid));
    LAS float* QB = (LAS float*)lds;
    LAS float* KB = QB + 64 * 33;
    LAS float* VS = KB + 64 * 33;
    LAS float* SS = VS + 4096;
    LAS float* ATT = SS + 2048;
    const int t0 = c * 64, lane = tid & 63, wv = tid >> 6;
    for (int h = 0; h < 4; ++h) {
        for (int idx = tid; idx < 2048; idx += NT) { const int tok = idx >> 5, d = idx & 31; const size_t t = (size_t)(t0 + tok);
            const float bb = W.GB[t * 128 + h * 32 + d];
            QB[tok * 33 + d] = bf2f(W.Z[t * NZ + C_DQ + h * 32 + d]) * 0.17677669529663687f * __expf(bb);
            KB[tok * 33 + d] = bf2f(W.Z[t * NZ + C_DK + h * 32 + d]) * __expf(-bb);
            SS[idx] = W.GDS[((size_t)(c * 4 + h) * 32) * 64 + idx]; }
        for (int idx = tid; idx < 4096; idx += NT) { const int tok = idx >> 6, v = idx & 63; VS[idx] = bf2f(W.Z[(size_t)(t0 + tok) * NZ + C_DV + h * 64 + v]); }
        __syncthreads();
#pragma unroll
        for (int k = 0; k < 8; ++k) { const int i = wv + 8 * k, jt = lane; float a = 0.f;
            if (jt <= i) {
#pragma unroll
                for (int d = 0; d < 32; ++d) a += QB[i * 33 + d] * KB[jt * 33 + d]; }
            ATT[i * 65 + jt] = a; }
        __syncthreads();
#pragma unroll
        for (int k = 0; k < 8; ++k) { const int i = wv + 8 * k, v = lane; float o = 0.f;
            for (int jt = 0; jt <= i; ++jt) o += ATT[i * 65 + jt] * VS[jt * 64 + v];
#pragma unroll
            for (int d = 0; d < 32; ++d) o += QB[i * 33 + d] * SS[d * 64 + v];
            const float ss = wave_sum(o * o); const size_t t = (size_t)(t0 + i);
            const float y = o * rsqrtf(ss * (1.0f / 64.0f) + EPS) * L.gla_n[h * 64 + v] * siluf_(bf2f(W.Z[t * NZ + C_DR + h * 64 + v]));
            W.Y[t * DM + 768 + h * 64 + v] = (bf16_t)f2bf(y); }
        __syncthreads();
    }
}

constexpr int PT_OFF = 131072 + 1024;
typedef volatile LAS unsigned long long* PtrTab;
__device__ __forceinline__ unsigned long long pt_ld(PtrTab PT, int i) { const unsigned long long v = PT[i]; const unsigned lo = __builtin_amdgcn_readfirstlane((unsigned)v), hi = __builtin_amdgcn_readfirstlane((unsigned)(v >> 32)); return ((unsigned long long)hi << 32) | lo; }
#define IN_(i) ((const float*)pt_ld(PT, (i)))
#define FRESH_IDS() int tid = threadIdx.x; asm volatile("" : "+v"(tid)); const int lane = tid & 63; const int wave = __builtin_amdgcn_readfirstlane(tid >> 6); const int gw = bid * NWAVES + wave, NGW = G * NWAVES; (void)lane; (void)gw; (void)NGW; \
    unsigned char* ws = (unsigned char*)pt_ld(PT, 30); float* out = (float*)pt_ld(PT, 29); (void)out
__device__ __forceinline__ WsP make_w(unsigned char* ws) {
    WsP W;
    W.XB = (bf16_t*)(ws + WS_XB); W.Z = (bf16_t*)(ws + WS_Z); W.Y = (bf16_t*)(ws + WS_Y); W.U = (bf16_t*)(ws + WS_U); W.MIX = (float*)(ws + WS_MIX);
    W.RSTD = (float*)(ws + WS_RSTD); W.DLR = (float*)(ws + WS_DLR); W.HLOC = (float*)(ws + WS_HLOC); W.PCUM = (float*)(ws + WS_PCUM);
    W.LA = (float*)(ws + WS_LAGG); W.LH = W.LA + 512 * 256; W.HIN = W.LH + 512 * 256;
    W.GDS = (float*)(ws + WS_GDS); W.GDEC = (float*)(ws + WS_GDEC); W.GB = (float*)(ws + WS_GB); W.BIAS = (float*)(ws + WS_BIAS);
    return W;
}
__device__ __forceinline__ LayerP make_l(PtrTab PT, int l) {
    LayerP L;
    L.l = l;
    L.conv_w = IN_(I_CONVW) + l * 1024; L.conv_b = IN_(I_CONVB) + l * 256; L.wa = IN_(I_WA) + l * 16384; L.ba = IN_(I_BA) + l * 256;
    L.wx = IN_(I_WX) + l * 16384; L.bx = IN_(I_BX) + l * 256; L.lam = IN_(I_LAM) + l * 256; L.pool_w = IN_(I_POOLW) + l * 16384; L.pool_s = IN_(I_POOLS) + l * 256;
    L.w_lr = IN_(I_WLR) + l * 2048; L.gla_b = IN_(I_GLAB) + l * 128; L.gla_n = IN_(I_GLAN) + l * 256;
    L.slh = IN_(I_SLH) + (size_t)l * NB * 256; L.slc = IN_(I_SLC) + (size_t)l * NB * 768; L.ck = IN_(I_CK) + (size_t)l * NB * 2048 * 256; L.cv = IN_(I_CV) + (size_t)l * NB * 2048 * 256;
    L.spool = IN_(I_SPOOL) + (size_t)l * NB * 3840; L.sgla = IN_(I_SGLA) + (size_t)l * NB * 8192;
    return L;
}

__global__ void __launch_bounds__(NT, 2) mk_fwd(Args args) {
    extern __shared__ __attribute__((aligned(16))) unsigned char lds_raw[];
    LAS unsigned char* lds = (LAS unsigned char*)lds_raw;
    cg::grid_group grid = cg::this_grid();
    const int G = gridDim.x, bid = blockIdx.x;
    volatile LAS unsigned* MISC = (volatile LAS unsigned*)(lds + MISC_OFF);
    PtrTab PT = (PtrTab)(lds + PT_OFF);
    if (threadIdx.x < 32) MISC[threadIdx.x] = 0u;
    if (threadIdx.x == 64) {
        PT[0] = (unsigned long long)args.in[0]; PT[1] = (unsigned long long)args.in[1]; PT[2] = (unsigned long long)args.in[2]; PT[3] = (unsigned long long)args.in[3];
        PT[4] = (unsigned long long)args.in[4]; PT[5] = (unsigned long long)args.in[5]; PT[6] = (unsigned long long)args.in[6]; PT[7] = (unsigned long long)args.in[7];
        PT[8] = (unsigned long long)args.in[8]; PT[9] = (unsigned long long)args.in[9]; PT[10] = (unsigned long long)args.in[10]; PT[11] = (unsigned long long)args.in[11];
        PT[12] = (unsigned long long)args.in[12]; PT[13] = (unsigned long long)args.in[13]; PT[14] = (unsigned long long)args.in[14]; PT[15] = (unsigned long long)args.in[15];
        PT[16] = (unsigned long long)args.in[16]; PT[17] = (unsigned long long)args.in[17]; PT[18] = (unsigned long long)args.in[18]; PT[19] = (unsigned long long)args.in[19];
        PT[20] = (unsigned long long)args.in[20]; PT[21] = (unsigned long long)args.in[21]; PT[22] = (unsigned long long)args.in[22]; PT[23] = (unsigned long long)args.in[23];
        PT[24] = (unsigned long long)args.in[24]; PT[25] = (unsigned long long)args.in[25]; PT[26] = (unsigned long long)args.in[26]; PT[27] = (unsigned long long)args.in[27];
        PT[28] = (unsigned long long)args.in[28]; PT[29] = (unsigned long long)args.out; PT[30] = (unsigned long long)args.ws;
    }
    __syncthreads();
    XcdBarrier bar = xcd_barrier_post((unsigned*)(args.ws + WS_CTL) + CW_BAR, MISC + 8);

    {
        FRESH_IDS(); const WsP W = make_w(ws);
        LAS float* scr = (LAS float*)(lds + wave * 16384);
        constexpr int I_IN = 16 * (NZ / 32), I_OUT = 16 * 32, I_UP = 16 * (FF / 32), I_DN = 64 * 32, I_L = I_IN + I_OUT + I_UP + I_DN;
        for (int it = gw; it < 2 * I_L; it += NGW) {
            const int l = it / I_L; int r = it % I_L;
            if (r < I_IN) { p0_transpose_item(IN_(I_WIN) + (size_t)l * DM * NIN, NIN, DM, NZ, IN_(I_NPREMIX) + l * DM, (bf16_t*)(ws + WS_WIN) + (size_t)l * NZ * DM, scr, r, lane); continue; } r -= I_IN;
            if (r < I_OUT) { p0_transpose_item(IN_(I_WOUT) + (size_t)l * DM * DM, DM, DM, DM, nullptr, (bf16_t*)(ws + WS_WOUT) + (size_t)l * DM * DM, scr, r, lane); continue; } r -= I_OUT;
            if (r < I_UP) { p0_transpose_item(IN_(I_WUP) + (size_t)l * DM * FF, FF, DM, FF, IN_(I_NPREMLP) + l * DM, (bf16_t*)(ws + WS_WUP) + (size_t)l * FF * DM, scr, r, lane); continue; } r -= I_UP;
            p0_transpose_item(IN_(I_WDOWN) + (size_t)l * FF * DM, DM, FF, DM, nullptr, (bf16_t*)(ws + WS_WDN) + (size_t)l * DM * FF, scr, r, lane);
        }
        { const float* relb = IN_(I_RELB); for (int i = bid * NT + tid; i < 4 * 388; i += G * NT) { const int h = i / 388, s = i % 388; W.BIAS[i] = (s < 387) ? relb[BUCKET[s] * 4 + h] : 0.f; } }
        for (int i = bid * NT + tid; i < (MROWS - NROWS) * DM / 8; i += G * NT) ((u32x4*)(W.XB + (size_t)NROWS * DM))[i] = (u32x4){0u, 0u, 0u, 0u};
        for (int i = bid * NT + tid; i < MROWS - NROWS; i += G * NT) W.RSTD[NROWS + i] = 0.f;
        __syncthreads();
        rowpass<false, true>(lds, IN_(I_XP), IN_(I_XS), nullptr, nullptr, nullptr, IN_(I_NPREMIX), IN_(I_WIN), W.XB, W.RSTD, W.DLR, gw, NGW, tid);
    }
    xcd_barrier(bar);

#pragma unroll 1
    for (int l = 0; l < 2; ++l) {
        {
            FRESH_IDS(); const WsP W = make_w(ws);
            pg8::Gemm g{W.XB, (const bf16_t*)(ws + WS_WIN) + (size_t)l * NZ * DM, MROWS, NZ, DM}; pg8::StaticOrder S; S.init(MROWS, NZ, G, bid);
            pg8::EpiScaleBf16<0> E{W.Z, NZ, W.RSTD};
#ifndef SK_GEMM
            pg8::gemm_phase<pg8::EpiScaleBf16<0>, pg8::StaticOrder, true, true>(lds, g, S, E);
#endif
        }
        xcd_barrier(bar);

        {
            FRESH_IDS(); const WsP W = make_w(ws); const LayerP L = make_l(PT, l);
            for (int tile = bid; tile < 256; tile += G) {
#ifndef SK_LRUL
                lru_local(lds, tile, L, W, out, tid);
#endif
#ifndef SK_GLAL
                gla_local(lds, tile, L, W, tid);
#endif
#ifndef SK_POOL
                pool_tile(lds, tile, L, W, out, tid);
#endif
 }
#ifndef SK_SAMP
            for (int b = bid; b < NB; b += G) sample_mixers(lds, b, L, W, out, tid);
#endif
#ifndef SK_ATTN
            for (int it = gw; it < TP * 4; it += NGW) attn_prompt_item((LAS float*)lds + wave * 400, W, it >> 2, it & 3, lane);
#endif
            for (int i = bid * NT + tid; i < 2 * 2048 * 256; i += G * NT) { const int which = i >> 19, r = (i >> 8) & 2047, c = i & 255;
                out[(which ? O_PV : O_PK) + (size_t)l * 524288 + r * 256 + c] = bf2f(W.Z[(size_t)(TP - 2048 + r) * NZ + (which ? C_BV : C_BK) + c]); }
        }
        xcd_barrier(bar);

        {
            FRESH_IDS(); const WsP W = make_w(ws); LayerP L; L.l = l;
#ifndef SK_SCAN
            for (int it = bid; it < 272; it += G) { if (it < 256) gla_scan_item(lds, it, L, W, out, tid); else lru_scan_item(lds, it - 256, L, W, out, tid); }
#endif
        }
        xcd_barrier(bar);

        {
            FRESH_IDS(); const WsP W = make_w(ws); const LayerP L = make_l(PT, l);
            for (int tile = bid; tile < 256; tile += G) {
#ifndef SK_LRUF
                lru_final(tile, L, W, tid);
#endif
#ifndef SK_GLAF
                gla_final(lds, tile, L, W, tid);
#endif
 }
        }
        xcd_barrier(bar);

        {
            FRESH_IDS(); const WsP W = make_w(ws);
            pg8::Gemm g{W.Y, (const bf16_t*)(ws + WS_WOUT) + (size_t)l * DM * DM, MROWS, DM, DM}; pg8::StaticOrder S; S.init(MROWS, DM, G, bid);
            pg8::EpiF32 E{W.MIX, DM};
#ifndef SK_GEMM
            pg8::gemm_phase<pg8::EpiF32, pg8::StaticOrder, true, true>(lds, g, S, E);
#endif
        }
        xcd_barrier(bar);
        {
            FRESH_IDS(); const WsP W = make_w(ws);
            rowpass<true, false>(lds, l == 0 ? IN_(I_XP) : out + O_YP, l == 0 ? IN_(I_XS) : out + O_YS, out, W.MIX, IN_(I_NPOSTMIX) + l * DM, nullptr, nullptr, W.XB, W.RSTD, W.DLR, gw, NGW, tid);
        }
        xcd_barrier(bar);
        {
            FRESH_IDS(); const WsP W = make_w(ws);
            pg8::Gemm g{W.XB, (const bf16_t*)(ws + WS_WUP) + (size_t)l * FF * DM, MROWS, FF, DM}; pg8::StaticOrder S; S.init(MROWS, FF, G, bid);
            pg8::EpiScaleBf16<1> E{W.U, FF, W.RSTD};
#ifndef SK_GEMM
            pg8::gemm_phase<pg8::EpiScaleBf16<1>, pg8::StaticOrder, true, true>(lds, g, S, E);
#endif
        }
        xcd_barrier(bar);
        {
            FRESH_IDS(); const WsP W = make_w(ws);
            pg8::Gemm g{W.U, (const bf16_t*)(ws + WS_WDN) + (size_t)l * DM * FF, MROWS, DM, FF}; pg8::StaticOrder S; S.init(MROWS, DM, G, bid);
            pg8::EpiF32 E{W.MIX, DM};
#ifndef SK_GEMM
            pg8::gemm_phase<pg8::EpiF32, pg8::StaticOrder, true, true>(lds, g, S, E);
#endif
        }
        xcd_barrier(bar);
        {
            FRESH_IDS(); const WsP W = make_w(ws);
#ifndef SK_ROWP
            if (l == 0) rowpass<true, true>(lds, out + O_YP, out + O_YS, out, W.MIX, IN_(I_NPOSTMLP) + l * DM, IN_(I_NPREMIX) + DM, IN_(I_WIN) + (size_t)DM * NIN, W.XB, W.RSTD, W.DLR, gw, NGW, tid);
            else        rowpass<true, false>(lds, out + O_YP, out + O_YS, out, W.MIX, IN_(I_NPOSTMLP) + l * DM, nullptr, nullptr, W.XB, W.RSTD, W.DLR, gw, NGW, tid);
#endif
        }
        if (l == 0) xcd_barrier(bar);
    }
    if (G == 0x7fffffff) grid.sync();
}

extern "C" void kernel_launch(void* const* d_in, const int* in_sizes, int n_in, void* d_out, int out_size, void* d_ws, size_t ws_size, hipStream_t stream) {
    static int grid = 0;
    if (grid == 0) {
        if (n_in != N_INPUTS || out_size != (int)O_END || ws_size < WS_END) { fprintf(stderr, "kernel_launch: unexpected sizes: n_in %d out %d ws %zu\n", n_in, out_size, ws_size); grid = -1; return; }
        int dev = 0, cus = 0, per_cu = 0;
        if (hipGetDevice(&dev) != hipSuccess || hipDeviceGetAttribute(&cus, hipDeviceAttributeMultiprocessorCount, dev) != hipSuccess) { grid = -1; return; }
        if (hipFuncSetAttribute((const void*)mk_fwd, hipFuncAttributeMaxDynamicSharedMemorySize, LDS_BYTES) != hipSuccess) { fprintf(stderr, "kernel_launch: hipFuncSetAttribute failed\n"); grid = -1; return; }
        if (hipOccupancyMaxActiveBlocksPerMultiprocessor(&per_cu, (const void*)mk_fwd, NT, LDS_BYTES) != hipSuccess || per_cu < 1) { fprintf(stderr, "kernel_launch: occupancy query says %d blocks per CU\n", per_cu); grid = -1; return; }
        grid = cus;
    }
    if (grid < 0) return;
    (void)hipMemsetAsync((char*)d_ws + WS_CTL, 0, CTL_ZERO_BYTES, stream);
    Args a{};
    for (int i = 0; i < N_INPUTS; ++i) a.in[i] = (const float*)d_in[i];
    a.out = (float*)d_out; a.ws = (unsigned char*)d_ws;
    void* kargs[] = {&a};
    hipError_t e = hipLaunchCooperativeKernel((const void*)mk_fwd, dim3(grid), dim3(NT), kargs, LDS_BYTES, stream);
    if (e != hipSuccess) fprintf(stderr, "cooperative launch failed: %s (grid %d)\n", hipGetErrorString(e), grid);
}
```

```cpp
#include <hip/hip_runtime.h>
#include <hip/hip_cooperative_groups.h>
#include <cstdio>
#include <cstdint>
namespace cg = cooperative_groups;
namespace pg8 {
#define PG8_LAS __attribute__((address_space(3)))
typedef unsigned short bf16_t;
typedef short bf16x8 __attribute__((ext_vector_type(8)));
typedef float f32x4 __attribute__((ext_vector_type(4)));
typedef unsigned u32x4 __attribute__((ext_vector_type(4)));
constexpr int BM = 256, BK = 64, HALF = 128, HTB = HALF * BK * 2  , STAGE_BYTES = 8 * HTB, NXCD = 8, WGM = 8;

__host__ __device__ __forceinline__ int lds_byte(int r, int c) { const int st = (r >> 4) * 2 + (c >> 5), rr = r & 15, cc = c & 31, ob = rr * 64 + cc * 2; return st * 1024 + (ob ^ (((ob >> 9) & 1) << 5)); }
__host__ __device__ __forceinline__ void stage_rc(int b, int& R, int& C) { const int st = b / 1024, sb = b % 1024, swz = sb ^ (((sb >> 9) & 1) << 5); R = (st >> 1) * 16 + swz / 64; C = (st & 1) * 32 + (swz % 64) / 2; }
__host__ __device__ __forceinline__ int perm32(int rho) { const int n = rho >> 4, i = rho & 15; return 8 * (i >> 2) + 4 * n + (i & 3); }

struct Unit { int pm, pn; };
struct Gemm { const bf16_t* A; const bf16_t* Bt; int M, N, K; };

struct StaticOrder {
    int nM, nN, nwg, G, c;
    __host__ __device__ void init(int M, int N, int G_, int c_) { nM = M / BM; nN = N / BM; nwg = nM * nN; G = G_; c = c_; }
    __host__ __device__ bool next(int i, Unit& u) const {
        const long L = (long)i * G + c; if (L >= nwg) return false;
        int wgid = (int)L; { const int q = nwg / NXCD, r = nwg % NXCD, xcd = wgid % NXCD, off = wgid / NXCD; wgid = (xcd < r ? xcd * (q + 1) : r * (q + 1) + (xcd - r) * q) + off; }
        const int nig = WGM * nN, gid = wgid / nig, fm = gid * WGM, gsz = (nM - fm) < WGM ? (nM - fm) : WGM;
        u.pm = fm + ((wgid % nig) % gsz); u.pn = (wgid % nig) / gsz; return true;
    }
    __device__ __forceinline__ void a_ready(const Unit&) const {}
    __device__ __forceinline__ void done(const Unit&) const {}
};

__device__ __forceinline__ unsigned cvt_pk_bf16(float lo, float hi) { unsigned r; asm volatile("v_cvt_pk_bf16_f32 %0, %1, %2" : "=v"(r) : "v"(lo), "v"(hi)); return r; }
template <int ACT> struct EpiScaleBf16 {
    static constexpr bool PERM = true, AFTER_DRAIN = false;
    bf16_t* O; int ldc; const float* rscale;
    __device__ __forceinline__ void operator()(const f32x4 (&acc)[2][2][4][2], const Unit& u, int wr, int wc, int fr, int fq) const {
        const int row0 = u.pm * BM + wr * 64 + fr; const int col0 = u.pn * BM + wc * 32 + 8 * fq;
#pragma unroll
        for (int ai = 0; ai < 2; ++ai)
#pragma unroll
            for (int m = 0; m < 4; ++m) { const int row = row0 + ai * HALF + m * 16; const float sc = rscale[row]; bf16_t* rowp = O + (size_t)row * ldc + col0;
#pragma unroll
                for (int bj = 0; bj < 2; ++bj) { f32x4 v0 = acc[ai][bj][m][0] * sc, v1 = acc[ai][bj][m][1] * sc;
                    if (ACT == 1) {
#pragma unroll
                        for (int e = 0; e < 4; ++e) { const float a = fmaxf(v0[e], 0.f), b = fmaxf(v1[e], 0.f); v0[e] = a * a; v1[e] = b * b; } }
                    u32x4 w; w.x = cvt_pk_bf16(v0[0], v0[1]); w.y = cvt_pk_bf16(v0[2], v0[3]); w.z = cvt_pk_bf16(v1[0], v1[1]); w.w = cvt_pk_bf16(v1[2], v1[3]);
                    *(u32x4*)(rowp + bj * HALF) = w; } }
    }
};
struct EpiF32 {
    static constexpr bool PERM = true, AFTER_DRAIN = false;
    float* O; int ldc;
    __device__ __forceinline__ void operator()(const f32x4 (&acc)[2][2][4][2], const Unit& u, int wr, int wc, int fr, int fq) const {
        const int row0 = u.pm * BM + wr * 64 + fr; const int col0 = u.pn * BM + wc * 32 + 8 * fq;
#pragma unroll
        for (int ai = 0; ai < 2; ++ai)
#pragma unroll
            for (int m = 0; m < 4; ++m) { float* rowp = O + (size_t)(row0 + ai * HALF + m * 16) * ldc + col0;
#pragma unroll
                for (int bj = 0; bj < 2; ++bj) { *(f32x4*)(rowp + bj * HALF) = acc[ai][bj][m][0]; *(f32x4*)(rowp + bj * HALF + 4) = acc[ai][bj][m][1]; } }
    }
};

template <class Epi, class Sched, bool ALIGN_EPI = false, bool SP2 = false>
__device__ __forceinline__ void gemm_phase(PG8_LAS unsigned char* lds, const Gemm g, const Sched& S, const Epi& E) {
    int tid_l = threadIdx.x; asm volatile("" : "+v"(tid_l));
    const int tid = tid_l, wid = __builtin_amdgcn_readfirstlane(tid >> 6), lane = tid & 63, wr = wid >> 2, wc = wid & 3, fr = lane & 15, fq = lane >> 4;
    const int K = g.K, nt = K / BK;
    unsigned voffA, voffB;
    { int R, C; stage_rc(tid * 16, R, C); const int Rb = Epi::PERM ? ((R & ~31) + perm32(R & 31)) : R;
        voffA = (unsigned)(R * K + C) * 2u; voffB = (unsigned)(Rb * K + C) * 2u; }
    const size_t rstep = (size_t)64 * K * 2;
    const size_t kstep = (size_t)(BK * 2);
    const size_t hstep = (size_t)HALF * K * 2;
    const size_t tstep = 2 * hstep;
    const unsigned ldsw = (unsigned)wid * 1024u;
    const int aoff = lds_byte(wr * 64 + fr, fq * 8), boff = lds_byte(wc * 32 + fr, fq * 8);
#define PG8_SA(b, h) (((b) * 2 + (h)) * HTB)
#define PG8_SB(b, h) ((4 + (b) * 2 + (h)) * HTB)
#define PG8_STAGE(bufoff, gbase, voff) do { _Pragma("unroll") for (int _i = 0; _i < 2; ++_i) \
        __builtin_amdgcn_global_load_lds((const unsigned*)((const char*)(gbase) + (size_t)_i * rstep + (voff)), (PG8_LAS unsigned*)(lds + (bufoff) + ldsw + _i * 8192), 16, 0, 0); } while (0)
#define PG8_LDA(dst, b, h) do { _Pragma("unroll") for (int m = 0; m < 4; ++m) _Pragma("unroll") for (int k = 0; k < 2; ++k) dst[m][k] = *(const PG8_LAS bf16x8*)(lds + PG8_SA(b, h) + aoff + m * 2048 + k * 1024); } while (0)
#define PG8_LDB(dst, b, h) do { _Pragma("unroll") for (int n = 0; n < 2; ++n) _Pragma("unroll") for (int k = 0; k < 2; ++k) dst[n][k] = *(const PG8_LAS bf16x8*)(lds + PG8_SB(b, h) + boff + n * 2048 + k * 1024); } while (0)
#define PG8_MMA(ai, bj, At, Bt) do { __builtin_amdgcn_s_setprio(1); _Pragma("unroll") for (int m = 0; m < 4; ++m) _Pragma("unroll") for (int n = 0; n < 2; ++n) _Pragma("unroll") for (int k = 0; k < 2; ++k) \
        acc[ai][bj][m][n] = __builtin_amdgcn_mfma_f32_16x16x32_bf16(Bt[n][k], At[m][k], acc[ai][bj][m][n], 0, 0, 0); __builtin_amdgcn_s_setprio(0); } while (0)
#define PG8_WAIT_V(n) asm volatile("s_waitcnt vmcnt(" #n ")" ::: "memory")
#define PG8_WAIT_L(n) asm volatile("s_waitcnt lgkmcnt(" #n ")" ::: "memory")
#define PG8_BAR __builtin_amdgcn_s_barrier()
#define PG8_SCHED __builtin_amdgcn_sched_barrier(0)
    Unit cur, nxt; int ui = 0;
    if (!S.next(0, cur)) return;
    f32x4 acc[2][2][4][2];
#pragma unroll
    for (int a = 0; a < 2; ++a)
#pragma unroll
        for (int b = 0; b < 2; ++b)
#pragma unroll
            for (int m = 0; m < 4; ++m)
#pragma unroll
                for (int n = 0; n < 2; ++n) acc[a][b][m][n] = (f32x4){0.f, 0.f, 0.f, 0.f};
    bf16x8 At[4][2], B0[2][2], B1[2][2];
    const char* cA = (const char*)g.A + (size_t)cur.pm * tstep; const char* cB = (const char*)g.Bt + (size_t)cur.pn * tstep;
    S.a_ready(cur);
    if constexpr (SP2) {
        PG8_STAGE(PG8_SB(0, 0), cB, voffB); PG8_STAGE(PG8_SB(0, 1), cB + hstep, voffB); PG8_STAGE(PG8_SA(0, 0), cA, voffA); PG8_STAGE(PG8_SA(0, 1), cA + hstep, voffA);
        if (wr == 1) PG8_BAR;
        PG8_WAIT_V(2); PG8_BAR;
        PG8_STAGE(PG8_SB(1, 0), cB + kstep, voffB); PG8_STAGE(PG8_SA(1, 0), cA + kstep, voffA); PG8_STAGE(PG8_SB(1, 1), cB + hstep + kstep, voffB);
        PG8_WAIT_V(6); PG8_BAR;
    } else {
        PG8_STAGE(PG8_SB(0, 0), cB, voffB); PG8_STAGE(PG8_SA(0, 0), cA, voffA); PG8_STAGE(PG8_SB(0, 1), cB + hstep, voffB); PG8_STAGE(PG8_SA(0, 1), cA + hstep, voffA);
        if (wr == 1) PG8_BAR;
        PG8_WAIT_V(4); PG8_BAR;
        PG8_STAGE(PG8_SB(1, 0), cB + kstep, voffB); PG8_STAGE(PG8_SA(1, 0), cA + kstep, voffA); PG8_STAGE(PG8_SB(1, 1), cB + hstep + kstep, voffB);
        PG8_WAIT_V(6); PG8_BAR;
    }
    for (;;) {
        const bool has_next = S.next(ui + 1, nxt);
        const char* nA = has_next ? (const char*)g.A + (size_t)nxt.pm * tstep : cA; const char* nB = has_next ? (const char*)g.Bt + (size_t)nxt.pn * tstep : cB;
        for (int t = 0; t < nt; t += 2) {
            const bool last = (t == nt - 2);
            const char* a1 = cA + (size_t)(t + 1) * kstep;
            const char* a2 = last ? nA : cA + (size_t)(t + 2) * kstep; const char* b2 = last ? nB : cB + (size_t)(t + 2) * kstep;
            const char* a3 = a2 + kstep; const char* b3 = b2 + kstep;
            if (last && has_next) S.a_ready(nxt);
            if constexpr (SP2) {
            PG8_LDB(B0, 0, 0); PG8_LDB(B1, 0, 1); PG8_SCHED; PG8_LDA(At, 0, 0); PG8_STAGE(PG8_SA(1, 1), a1 + hstep, voffA);
            PG8_WAIT_V(8); PG8_WAIT_L(0); PG8_BAR; PG8_MMA(0, 0, At, B0); PG8_MMA(0, 1, At, B1); PG8_BAR; PG8_SCHED;
            PG8_LDA(At, 0, 1); PG8_STAGE(PG8_SB(0, 0), b2, voffB); PG8_STAGE(PG8_SB(0, 1), b2 + hstep, voffB); PG8_STAGE(PG8_SA(0, 0), a2, voffA);
            PG8_WAIT_V(8); PG8_WAIT_L(0); PG8_BAR; PG8_MMA(1, 0, At, B0); PG8_MMA(1, 1, At, B1); PG8_BAR; PG8_SCHED;
            PG8_LDB(B0, 1, 0); PG8_LDB(B1, 1, 1); PG8_SCHED; PG8_LDA(At, 1, 0); PG8_STAGE(PG8_SA(0, 1), a2 + hstep, voffA);
            PG8_WAIT_V(8); PG8_WAIT_L(0); PG8_BAR; PG8_MMA(0, 0, At, B0); PG8_MMA(0, 1, At, B1); PG8_BAR; PG8_SCHED;
            PG8_LDA(At, 1, 1); PG8_STAGE(PG8_SB(1, 0), b3, voffB); PG8_STAGE(PG8_SB(1, 1), b3 + hstep, voffB); PG8_STAGE(PG8_SA(1, 0), a3, voffA);
            PG8_WAIT_V(8); PG8_WAIT_L(0); PG8_BAR; PG8_MMA(1, 0, At, B0); PG8_MMA(1, 1, At, B1); PG8_BAR; PG8_SCHED;
            } else {
            PG8_LDB(B0, 0, 0); PG8_SCHED; PG8_LDA(At, 0, 0); PG8_STAGE(PG8_SA(1, 1), a1 + hstep, voffA);
            PG8_WAIT_L(8); PG8_BAR; PG8_WAIT_L(0); PG8_MMA(0, 0, At, B0); PG8_BAR; PG8_SCHED;
            PG8_LDB(B1, 0, 1); PG8_STAGE(PG8_SB(0, 0), b2, voffB);
            PG8_BAR; PG8_WAIT_L(0); PG8_MMA(0, 1, At, B1); PG8_BAR;
            PG8_LDA(At, 0, 1); PG8_STAGE(PG8_SA(0, 0), a2, voffA);
            PG8_BAR; PG8_WAIT_L(0); PG8_MMA(1, 0, At, B0); PG8_BAR; PG8_SCHED;
            PG8_STAGE(PG8_SB(0, 1), b2 + hstep, voffB);
            PG8_WAIT_V(6); PG8_BAR; PG8_MMA(1, 1, At, B1); PG8_BAR;
            PG8_LDB(B0, 1, 0); PG8_SCHED; PG8_LDA(At, 1, 0); PG8_STAGE(PG8_SA(0, 1), a2 + hstep, voffA);
            PG8_WAIT_L(8); PG8_BAR; PG8_WAIT_L(0); PG8_MMA(0, 0, At, B0); PG8_BAR; PG8_SCHED;
            PG8_LDB(B1, 1, 1); PG8_STAGE(PG8_SB(1, 0), b3, voffB);
            PG8_BAR; PG8_WAIT_L(0); PG8_MMA(0, 1, At, B1); PG8_BAR;
            PG8_LDA(At, 1, 1); PG8_STAGE(PG8_SA(1, 0), a3, voffA);
            PG8_BAR; PG8_WAIT_L(0); PG8_MMA(1, 0, At, B0); PG8_BAR; PG8_SCHED;
            PG8_STAGE(PG8_SB(1, 1), b3 + hstep, voffB);
            PG8_WAIT_V(6); PG8_BAR; PG8_MMA(1, 1, At, B1); PG8_BAR;
            }
        }
        if constexpr (ALIGN_EPI) { if (wr == 0) PG8_BAR; }
        if constexpr (!Epi::AFTER_DRAIN) { E(acc, cur, wr, wc, fr, fq); S.done(cur); }
        if (!has_next) break;
#pragma unroll
        for (int a = 0; a < 2; ++a)
#pragma unroll
            for (int b = 0; b < 2; ++b)
#pragma unroll
                for (int m = 0; m < 4; ++m)
#pragma unroll
                    for (int n = 0; n < 2; ++n) acc[a][b][m][n] = (f32x4){0.f, 0.f, 0.f, 0.f};
        cur = nxt; cA = nA; cB = nB; ++ui;
        if constexpr (ALIGN_EPI) { if (wr == 1) PG8_BAR; }
    }
    PG8_WAIT_V(0);
    if constexpr (!ALIGN_EPI) { if (wr == 0) PG8_BAR; }
    PG8_BAR;
    if constexpr (Epi::AFTER_DRAIN) { E.fused(acc, cur, wr, wc, fr, fq, lds, wid, lane); S.done(cur); }
#undef PG8_SA
#undef PG8_SB
#undef PG8_STAGE
#undef PG8_LDA
#undef PG8_LDB
#undef PG8_MMA
#undef PG8_WAIT_V
#undef PG8_WAIT_L
#undef PG8_BAR
#undef PG8_SCHED
}
}

#define GAS __attribute__((address_space(1)))
#define LAS __attribute__((address_space(3)))
typedef unsigned short bf16_t;
typedef float f32x4 __attribute__((ext_vector_type(4)));
typedef unsigned u32x4 __attribute__((ext_vector_type(4)));
typedef unsigned u32x2 __attribute__((ext_vector_type(2)));

constexpr int NT = 512, NWAVES = 8;
constexpr int DM = 1024, TP = 16384, NB = 32, MROWS = 16640, NROWS = TP + NB, NZ = 2304, NIN = 2320, FF = 4096;
constexpr float EPS = 1e-6f;
constexpr int C_AU = 0, C_AG = 256, C_BQ = 512, C_BK = 768, C_BV = 1024, C_CU = 1280, C_DQ = 1536, C_DK = 1664, C_DV = 1792, C_DR = 2048;
enum { I_XP = 0, I_XS, I_SLH, I_SLC, I_CK, I_CV, I_SPOOL, I_SGLA, I_NPREMIX, I_NPOSTMIX, I_NPREMLP, I_NPOSTMLP, I_WIN, I_CONVW, I_CONVB, I_WA, I_BA, I_WX, I_BX, I_LAM, I_RELB, I_POOLW, I_POOLS, I_WLR, I_GLAB, I_GLAN, I_WOUT, I_WUP, I_WDOWN, N_INPUTS };
constexpr size_t O_YP = 0, O_YS = O_YP + (size_t)TP * DM, O_PH = O_YS + NB * DM, O_PC = O_PH + 2 * 256, O_PK = O_PC + 2 * 3 * 256, O_PV = O_PK + 2 * 2048 * 256,
                 O_PP = O_PV + 2 * 2048 * 256, O_PG = O_PP + 2 * 15 * 256, O_SH = O_PG + 2 * 8192, O_SC = O_SH + 2 * NB * 256, O_SK = O_SC + 2 * NB * 3 * 256,
                 O_SV = O_SK + 2 * NB * 256, O_SP = O_SV + 2 * NB * 256, O_SG = O_SP + 2 * NB * 15 * 256, O_END = O_SG + 2 * NB * 8192;
static_assert(O_END == 19801600, "output size");
constexpr size_t MiB = 1u << 20;
constexpr size_t WS_CTL = 0, CTL_ZERO_BYTES = 1 * MiB;
constexpr size_t WS_WIN = 2 * MiB, WS_WOUT = 11 * MiB, WS_WUP = 15 * MiB, WS_WDN = 31 * MiB;
constexpr size_t WS_XB = 47 * MiB, WS_Z = 80 * MiB, WS_Y = 154 * MiB, WS_MIX = 187 * MiB, WS_U = 252 * MiB;
constexpr size_t WS_RSTD = 382 * MiB, WS_DLR = 383 * MiB, WS_HLOC = 385 * MiB, WS_PCUM = 401 * MiB, WS_LAGG = 417 * MiB;
constexpr size_t WS_GDS = 419 * MiB, WS_GDEC = 427 * MiB, WS_GB = 428 * MiB, WS_BIAS = 436 * MiB, WS_PART = 437 * MiB, WS_END = 438 * MiB;
constexpr int CW_BAR = 4096;
constexpr int LDS_BYTES = 147456, MISC_OFF = 131072 + 320;

__constant__ unsigned char BUCKET[387] = {
0,1,2,3,4,5,6,7,8,9,10,11,12,13,14,15,16,16,16,16,16,16,17,17,17,17,17,17,17,17,18,18,18,18,18,18,18,18,18,18,19,19,19,19,19,19,19,19,19,19,19,19,19,19,20,20,20,20,20,20,20,20,20,20,20,20,20,20,20,20,20,20,20,21,21,21,21,21,21,21,21,21,21,21,21,21,21,21,21,21,21,21,21,21,21,21,21,21,21,22,22,22,22,22,22,22,22,22,22,22,22,22,22,22,22,22,22,22,22,22,22,22,22,22,22,22,22,22,22,
0,4,8,12,16,16,17,17,18,18,19,19,19,19,20,20,20,20,20,21,21,21,21,21,21,22,22,22,22,22,22,22,22,22,23,23,23,23,23,23,23,23,23,23,23,23,24,24,24,24,24,24,24,24,24,24,24,24,24,24,24,24,25,25,25,25,25,25,25,25,25,25,25,25,25,25,25,25,25,25,25,25,25,26,26,26,26,26,26,26,26,26,26,26,26,26,26,26,26,26,26,26,26,26,26,26,26,26,26,26,26,26,26,27,27,27,27,27,27,27,27,27,27,27,27,27,27,27,27,
0,16,18,19,20,21,21,22,22,23,23,23,24,24,24,24,25,25,25,25,25,26,26,26,26,26,26,26,26,27,27,27,27,27,27,27,27,27,27,28,28,28,28,28,28,28,28,28,28,28,28,28,29,29,29,29,29,29,29,29,29,29,29,29,29,29,29,29,29,29,30,30,30,30,30,30,30,30,30,30,30,30,30,30,30,30,30,30,30,30,30,30,30,30,30,31,31,31,31,31,31,31,31,31,31,31,31,31,31,31,31,31,31,31,31,31,31,31,31,31,31,31,31,31,31,31,31,31,31};

#define XB_TMO      128
#define XB_XCNT(j)  (256  + 64 * (j))
#define XB_XSUB(j)  (1280 + 64 * (j))
#define XB_XGEN(j)  (2304 + 64 * (j))
#define XB_TOP      3328
#define XB_TOPGEN   3392
#define XCD_BAR_WORDS 3456
#define XB_SPIN_CAP (1u << 18)
__device__ __forceinline__ unsigned xb_ld(unsigned* p)              { return __hip_atomic_load(p, __ATOMIC_RELAXED, __HIP_MEMORY_SCOPE_AGENT); }
__device__ __forceinline__ unsigned xb_add(unsigned* p, unsigned v) { return __hip_atomic_fetch_add(p, v, __ATOMIC_RELAXED, __HIP_MEMORY_SCOPE_AGENT); }
__device__ __forceinline__ unsigned xb_xcc_id() { return (unsigned)__builtin_amdgcn_s_getreg((3 << 11) | 20) & 0xFu; }
#define XB_SPIN(cond, bar) do { unsigned _sp = 0; while (cond) { __builtin_amdgcn_s_sleep(1); \
    if ((++_sp & 255u) == 0u) { if (xb_ld(&(bar)[XB_TMO])) break; if (_sp > XB_SPIN_CAP) { atomicAdd(&(bar)[XB_TMO], 1u); break; } } } } while (0)
struct XcdBarrier { unsigned* bar; unsigned x; volatile LAS unsigned* st; };
__device__ __forceinline__ XcdBarrier xcd_barrier_post(unsigned* bar, volatile LAS unsigned* st) {
    XcdBarrier b; b.bar = bar; b.x = xb_xcc_id(); b.st = st;
    if (threadIdx.x == 0) (void)xb_add(&bar[XB_XCNT(b.x)], 1u);
    return b;
}
__device__ __forceinline__ void xcd_barrier_complete(unsigned* bar, unsigned x, unsigned& nloc, unsigned& nx) {
    const unsigned G = gridDim.x * gridDim.y * gridDim.z;
    unsigned sum, cnt, mine, sp = 0u;
    for (;;) {
        sum = 0u; cnt = 0u; mine = 0u;
#pragma unroll
        for (unsigned j = 0; j < 16; ++j) { const unsigned c = xb_ld(&bar[XB_XCNT(j)]); sum += c; cnt += (c > 0u) ? 1u : 0u; mine = (j == x) ? c : mine; }
        if (sum == G) break;
        __builtin_amdgcn_s_sleep(1);
        if ((++sp & 255u) == 0u) { if (xb_ld(&bar[XB_TMO])) break; if (sp > XB_SPIN_CAP) { atomicAdd(&bar[XB_TMO], 1u); break; } }
    }
    nloc = mine > 0u ? mine : 1u; nx = cnt > 0u ? cnt : 1u;
}
__device__ __forceinline__ void xcd_barrier(const XcdBarrier& b) {
    asm volatile("s_waitcnt vmcnt(0)" ::: "memory");
    __syncthreads();
    if (threadIdx.x == 0) {
        unsigned* bar = b.bar;
        __builtin_amdgcn_s_waitcnt(0);
        unsigned nloc = b.st[0], nx = b.st[1];
        if (nloc == 0u) { xcd_barrier_complete(bar, b.x, nloc, nx); b.st[0] = nloc; b.st[1] = nx; }
        const unsigned old = xb_add(&bar[XB_XSUB(b.x)], 1u);
        const unsigned gen = old / nloc;
        if (old + 1u == (gen + 1u) * nloc) {
            __builtin_amdgcn_fence(__ATOMIC_RELEASE, "agent");
            asm volatile("s_waitcnt vmcnt(0)" ::: "memory");
            const unsigned og = xb_add(&bar[XB_TOP], 1u);
            const unsigned tg = og / nx;
            if (og + 1u == (tg + 1u) * nx) xb_add(&bar[XB_TOPGEN], 1u);
            else XB_SPIN(xb_ld(&bar[XB_TOPGEN]) == tg, bar);
            __builtin_amdgcn_fence(__ATOMIC_ACQUIRE, "agent");
            xb_add(&bar[XB_XGEN(b.x)], 1u);
            asm volatile("s_waitcnt vmcnt(0)" ::: "memory");
        } else {
            XB_SPIN(xb_ld(&bar[XB_XGEN(b.x)]) == gen, bar);
            __builtin_amdgcn_fence(__ATOMIC_ACQUIRE, "agent");
            asm volatile("s_waitcnt vmcnt(0)" ::: "memory");
        }
    }
    __syncthreads();
}

#define LDS_WAIT() asm volatile("s_waitcnt lgkmcnt(0)" ::: "memory")
__device__ __forceinline__ float bf2f(bf16_t b) { return __uint_as_float((unsigned)b << 16); }
__device__ __forceinline__ float bflo(unsigned w) { return __uint_as_float(w << 16); }
__device__ __forceinline__ float bfhi(unsigned w) { return __uint_as_float(w & 0xffff0000u); }
__device__ __forceinline__ unsigned f2bf(float f) { unsigned u = __float_as_uint(f); return (u + 0x7fffu + ((u >> 16) & 1u)) >> 16; }
__device__ __forceinline__ unsigned pk2(float lo, float hi) { return f2bf(lo) | (f2bf(hi) << 16); }
__device__ __forceinline__ float wave_sum(float v) {
#pragma unroll
    for (int o = 1; o < 64; o <<= 1) v += __shfl_xor(v, o);
    return v;
}
__device__ __forceinline__ float wave_max(float v) {
#pragma unroll
    for (int o = 1; o < 64; o <<= 1) v = fmaxf(v, __shfl_xor(v, o));
    return v;
}
__device__ __forceinline__ float sigmoidf_(float x) { return 1.0f / (1.0f + __expf(-x)); }
__device__ __forceinline__ float logsigmoidf_(float x) { return fminf(x, 0.f) - log1pf(__expf(-fabsf(x))); }
__device__ __forceinline__ float gelu_tanh(float x) { const float u = 0.7978845608028654f * (x + 0.044715f * x * x * x); return 0.5f * x * (1.0f + tanhf(u)); }
__device__ __forceinline__ float siluf_(float x) { return x / (1.0f + __expf(-x)); }

struct Args { const float* in[N_INPUTS]; float* out; unsigned char* ws; };

__device__ __forceinline__ void p0_transpose_item(const float* W, int ldw, int K, int Ncols, const float* kscale, bf16_t* WT, LAS float* scr, int item, int lane) {
    const int nblk = Ncols / 32, kb = item / nblk, nb = item % nblk, k0 = 64 * kb, n0 = 32 * nb;
#pragma unroll 8
    for (int i = 0; i < 32; ++i) { const int kk = 2 * i + (lane >> 5); const float s = kscale ? kscale[k0 + kk] : 1.0f; scr[kk * 33 + (lane & 31)] = W[(size_t)(k0 + kk) * ldw + n0 + (lane & 31)] * s; }
    LDS_WAIT(); asm volatile("" ::: "memory");
    const int c = lane & 7;
#pragma unroll
    for (int j = 0; j < 4; ++j) { const int n = (lane >> 3) + 8 * j; const LAS float* s = scr + (8 * c) * 33 + n;
        u32x4 o; o.x = pk2(s[0 * 33], s[1 * 33]); o.y = pk2(s[2 * 33], s[3 * 33]); o.z = pk2(s[4 * 33], s[5 * 33]); o.w = pk2(s[6 * 33], s[7 * 33]);
        *(u32x4*)(WT + (size_t)(n0 + n) * K + k0 + 8 * c) = o; }
    LDS_WAIT(); asm volatile("" ::: "memory");
}

template <bool HAS_MIX, bool WANT_DLR>
__device__ __forceinline__ void rowpass(LAS unsigned char* lds, const float* xsrcP, const float* xsrcS, float* xdst, const float* mix, const float* gpost,
                                        const float* gpre_next, const float* win_next, bf16_t* XB, float* RSTD, float* DLR, int gw, int NGW, int tid) {
    const int lane = tid & 63;
    LAS float* WLT = (LAS float*)lds;
    if (WANT_DLR) {
        for (int idx = tid; idx < 16384; idx += NT) { const int k = idx >> 4, j = idx & 15; WLT[j * 1028 + k] = gpre_next[k] * win_next[(size_t)k * NIN + NZ + j]; }
        __syncthreads();
    }
    for (int row = gw; row < NROWS; row += NGW) {
        const float* xs = (row < TP) ? xsrcP + (size_t)row * DM : xsrcS + (size_t)(row - TP) * DM;
        f32x4 v[4];
#pragma unroll
        for (int j = 0; j < 4; ++j) v[j] = *(const f32x4*)(xs + 4 * lane + 256 * j);
        if (HAS_MIX) {
            f32x4 mv[4]; float s = 0.f;
#pragma unroll
            for (int j = 0; j < 4; ++j) { mv[j] = *(const f32x4*)(mix + (size_t)row * DM + 4 * lane + 256 * j); s += (mv[j].x * mv[j].x + mv[j].y * mv[j].y) + (mv[j].z * mv[j].z + mv[j].w * mv[j].w); }
            const float rm = rsqrtf(wave_sum(s) * (1.0f / DM) + EPS);
#pragma unroll
            for (int j = 0; j < 4; ++j) { const f32x4 g = *(const f32x4*)(gpost + 4 * lane + 256 * j); v[j] = v[j] + mv[j] * rm * g; }
        }
        if (xdst) {
#pragma unroll
            for (int j = 0; j < 4; ++j) *(f32x4*)(xdst + (size_t)row * DM + 4 * lane + 256 * j) = v[j];
        }
        float s2 = 0.f;
#pragma unroll
        for (int j = 0; j < 4; ++j) s2 += (v[j].x * v[j].x + v[j].y * v[j].y) + (v[j].z * v[j].z + v[j].w * v[j].w);
        const float rstd = rsqrtf(wave_sum(s2) * (1.0f / DM) + EPS);
        if (lane == 0) RSTD[row] = rstd;
#pragma unroll
        for (int j = 0; j < 4; ++j) { u32x2 w; w.x = pk2(v[j].x, v[j].y); w.y = pk2(v[j].z, v[j].w); *(u32x2*)(XB + (size_t)row * DM + 4 * lane + 256 * j) = w; }
        if (WANT_DLR) {
            float mine = 0.f; int lo = 4 * lane; asm volatile("" : "+v"(lo));
#pragma unroll
            for (int jj = 0; jj < 16; ++jj) {
                float a = 0.f;
#pragma unroll
                for (int j = 0; j < 4; ++j) { const f32x4 w = *(const LAS f32x4*)(WLT + jj * 1028 + lo + 256 * j); a += (v[j].x * w.x + v[j].y * w.y) + (v[j].z * w.z + v[j].w * w.w); }
                a = wave_sum(a);
                if ((lo >> 2) == jj) mine = a;
            }
            if (lane < 16) DLR[(size_t)row * 16 + lane] = mine * rstd;
        }
    }
    if (WANT_DLR) __syncthreads();
}

struct LayerP {
    const float *conv_w, *conv_b, *wa, *ba, *wx, *bx, *lam, *pool_w, *pool_s, *w_lr, *gla_b, *gla_n;
    const float *slh, *slc, *ck, *cv, *spool, *sgla;
    int l;
};
struct WsP { bf16_t *XB, *Z, *Y, *U; float *MIX, *RSTD, *DLR, *HLOC, *PCUM, *LA, *LH, *HIN, *GDS, *GDEC, *GB, *BIAS; };

constexpr int XS = 68;

__device__ __forceinline__ void lru_local(LAS unsigned char* lds, int tile, const LayerP& L, const WsP& W, float* out, int tid) {
    asm volatile("" : "+v"(tid));
    LAS float* XT = (LAS float*)lds;
    const int ch = tid & 255, half = tid >> 8, h = ch >> 6, j = ch & 63;
    const int t0 = tile * 64 + half * 32;
    const bf16_t* zc = W.Z + C_AU + ch;
    const float w0 = L.conv_w[ch], w1 = L.conv_w[256 + ch], w2 = L.conv_w[512 + ch], w3 = L.conv_w[768 + ch], cb = L.conv_b[ch];
    float am3 = (t0 >= 3) ? bf2f(zc[(size_t)(t0 - 3) * NZ]) : 0.f, am2 = (t0 >= 3) ? bf2f(zc[(size_t)(t0 - 2) * NZ]) : 0.f, am1 = (t0 >= 3) ? bf2f(zc[(size_t)(t0 - 1) * NZ]) : 0.f;
    float u[32];
#pragma unroll
    for (int tok = 0; tok < 32; ++tok) { const float a0 = bf2f(zc[(size_t)(t0 + tok) * NZ]); u[tok] = cb + w0 * am3 + w1 * am2 + w2 * am1 + w3 * a0; am3 = am2; am2 = am1; am1 = a0;
        XT[ch * XS + half * 32 + tok] = u[tok]; }
    if (tile == 255 && half == 1) { float* o = out + O_PC + (size_t)L.l * 768 + ch; o[0] = am3; o[256] = am2; o[512] = am1; }
    __syncthreads();
    float r[32], gi[32];
#pragma unroll
    for (int tok = 0; tok < 32; ++tok) { r[tok] = 0.f; gi[tok] = 0.f; }
    const float* wa = L.wa + h * 4096 + j; const float* wx = L.wx + h * 4096 + j;
    for (int i = 0; i < 64; ++i) {
        const float a_ = wa[i * 64], x_ = wx[i * 64];
        const LAS f32x4* xr = (const LAS f32x4*)(XT + (h * 64 + i) * XS + half * 32);
#pragma unroll
        for (int q = 0; q < 8; ++q) { const f32x4 xv = xr[q];
#pragma unroll
            for (int e = 0; e < 4; ++e) { r[4 * q + e] += xv[e] * a_; gi[4 * q + e] += xv[e] * x_; } }
    }
    const float ba = L.ba[ch], bx = L.bx[ch], c8 = -8.0f * log1pf(__expf(-L.lam[ch]));
    float P = 1.f, hl = 0.f;
#pragma unroll
    for (int tok = 0; tok < 32; ++tok) {
        const float rr = sigmoidf_(r[tok] + ba), gg = sigmoidf_(gi[tok] + bx), la = c8 * rr, a = __expf(la);
        const float inp = sqrtf(-expm1f(2.0f * la)) * (gg * u[tok]);
        hl = a * hl + inp; P *= a;
        W.HLOC[(size_t)(t0 + tok) * 256 + ch] = hl; W.PCUM[(size_t)(t0 + tok) * 256 + ch] = P;
    }
    const int seg = tile * 2 + half;
    W.LA[seg * 256 + ch] = P; W.LH[seg * 256 + ch] = hl;
    __syncthreads();
}

__device__ __forceinline__ void gla_local(LAS unsigned char* lds, int c, const LayerP& L, const WsP& W, int tid) {
    asm volatile("" : "+v"(tid));
    LAS float* Bc = (LAS float*)lds;
    LAS float* Kd = Bc + 8192;
    LAS float* Vs = Kd + 8192;
    const int t0 = c * 64;
    {
        const int n = tid & 127, q = tid >> 7;
        float wl[16];
#pragma unroll
        for (int jj = 0; jj < 16; ++jj) wl[jj] = L.w_lr[jj * 128 + n];
        const float gb = L.gla_b[n];
        for (int tt = 0; tt < 16; ++tt) { const int tok = q * 16 + tt; const float* d = W.DLR + (size_t)(t0 + tok) * 16; float a = gb;
#pragma unroll
            for (int jj = 0; jj < 16; ++jj) a += d[jj] * wl[jj];
            Bc[tok * 128 + n] = logsigmoidf_(a) * (1.0f / 16.0f); }
    }
    __syncthreads();
    if (tid < 128) { float s = 0.f; for (int tok = 0; tok < 64; ++tok) { s += Bc[tok * 128 + tid]; Bc[tok * 128 + tid] = s; W.GB[(size_t)(t0 + tok) * 128 + tid] = s; } }
    for (int idx = tid; idx < 64 * 16; idx += NT) { const int tok = idx >> 4, c8 = idx & 15; const u32x4 v = *(const u32x4*)(W.Z + (size_t)(t0 + tok) * NZ + C_DK + c8 * 8); LAS float* o = Kd + tok * 128 + c8 * 8;
        o[0] = bflo(v.x); o[1] = bfhi(v.x); o[2] = bflo(v.y); o[3] = bfhi(v.y); o[4] = bflo(v.z); o[5] = bfhi(v.z); o[6] = bflo(v.w); o[7] = bfhi(v.w); }
    for (int idx = tid; idx < 64 * 32; idx += NT) { const int tok = idx >> 5, c8 = idx & 31; const u32x4 v = *(const u32x4*)(W.Z + (size_t)(t0 + tok) * NZ + C_DV + c8 * 8); LAS float* o = Vs + tok * 256 + c8 * 8;
        o[0] = bflo(v.x); o[1] = bfhi(v.x); o[2] = bflo(v.y); o[3] = bfhi(v.y); o[4] = bflo(v.z); o[5] = bfhi(v.z); o[6] = bflo(v.w); o[7] = bfhi(v.w); }
    __syncthreads();
    for (int idx = tid; idx < 8192; idx += NT) { const int n = idx & 127; Kd[idx] *= __expf(Bc[63 * 128 + n] - Bc[idx]); }
    __syncthreads();
    {
        const int h = tid >> 7, dk = (tid & 127) >> 2, dv0 = (tid & 3) * 16;
        float acc[16];
#pragma unroll
        for (int e = 0; e < 16; ++e) acc[e] = 0.f;
        for (int jt = 0; jt < 64; ++jt) { const float kd = Kd[jt * 128 + h * 32 + dk]; const LAS f32x4* vp = (const LAS f32x4*)(Vs + jt * 256 + h * 64 + dv0);
#pragma unroll
            for (int q = 0; q < 4; ++q) { const f32x4 vv = vp[q];
#pragma unroll
                for (int e = 0; e < 4; ++e) acc[4 * q + e] += kd * vv[e]; } }
        float* o = W.GDS + ((size_t)(c * 4 + h) * 32 + dk) * 64 + dv0;
#pragma unroll
        for (int q = 0; q < 4; ++q) *(f32x4*)(o + 4 * q) = (f32x4){acc[4 * q], acc[4 * q + 1], acc[4 * q + 2], acc[4 * q + 3]};
        if ((tid & 3) == 0) W.GDEC[c * 128 + h * 32 + dk] = __expf(Bc[63 * 128 + h * 32 + dk]);
    }
    __syncthreads();
}

__device__ __forceinline__ void pool_tile(LAS unsigned char* lds, int tile, const LayerP& L, const WsP& W, float* out, int tid) {
    asm volatile("" : "+v"(tid));
    LAS float* PT = (LAS float*)lds;
    LAS bf16_t* CU = (LAS bf16_t*)(lds + 256 * XS * 4);
    const int t0 = tile * 64;
    for (int idx = tid; idx < 79 * 32; idx += NT) { const int r = idx >> 5, c8 = idx & 31; const int t = t0 - 15 + r;
        u32x4 v = (u32x4){0u, 0u, 0u, 0u}; if (t >= 0) v = *(const u32x4*)(W.Z + (size_t)t * NZ + C_CU + c8 * 8);
        *(LAS u32x4*)(CU + r * 256 + c8 * 8) = v; }
    __syncthreads();
    const int ch = tid & 255, half = tid >> 8, g = ch >> 6, w = 2 << g;
    if (tile == 255) { for (int r = 64 + half; r < 79; r += 2) out[O_PP + (size_t)L.l * 3840 + (r - 64) * 256 + ch] = bf2f(CU[r * 256 + ch]); }
    for (int tok = 0; tok < 32; ++tok) { const int tl = half * 32 + tok, t = t0 + tl; float s = 0.f;
        for (int i = 0; i < w; ++i) s += bf2f(CU[(15 + tl - i) * 256 + ch]);
        const float cnt = (float)((t + 1 < w) ? (t + 1) : w);
        PT[ch * XS + tl] = s / cnt - bf2f(CU[(15 + tl) * 256 + ch]); }
    __syncthreads();
    float acc[32];
#pragma unroll
    for (int tok = 0; tok < 32; ++tok) acc[tok] = 0.f;
    const float* wp = L.pool_w + g * 4096 + (ch & 63);
    for (int i = 0; i < 64; ++i) { const float w_ = wp[i * 64]; const LAS f32x4* xr = (const LAS f32x4*)(PT + (g * 64 + i) * XS + half * 32);
#pragma unroll
        for (int q = 0; q < 8; ++q) { const f32x4 xv = xr[q];
#pragma unroll
            for (int e = 0; e < 4; ++e) acc[4 * q + e] += xv[e] * w_; } }
    const float sc = L.pool_s[ch];
#pragma unroll
    for (int tok = 0; tok < 32; ++tok) W.Y[(size_t)(t0 + half * 32 + tok) * DM + 512 + ch] = (bf16_t)f2bf(acc[tok] * sc);
    __syncthreads();
}

__device__ __forceinline__ void unpack8(const u32x4 v, float* d) { d[0] = bflo(v.x); d[1] = bfhi(v.x); d[2] = bflo(v.y); d[3] = bfhi(v.y); d[4] = bflo(v.z); d[5] = bfhi(v.z); d[6] = bflo(v.w); d[7] = bfhi(v.w); }

__device__ __forceinline__ void attn_prompt_item(LAS float* PL, const WsP& W, int t, int h, int lane) {
    asm volatile("" : "+v"(lane));
    const int sg = lane >> 3, dg = lane & 7;
    float q[8]; unpack8(*(const u32x4*)(W.Z + (size_t)t * NZ + C_BQ + h * 64 + dg * 8), q);
    const bf16_t* kbase = W.Z + C_BK + h * 64 + dg * 8;
    const bf16_t* vbase = W.Z + C_BV + h * 64 + dg * 8;
    float m = -3.0e38f;
#pragma unroll 7
    for (int i = 0; i < 49; ++i) {
        const int s = i * 8 + sg; const int p = (s >= 258) ? 2 : ((s >= 129) ? 1 : 0); const int jj = s - 129 * p; const int ps = t - (jj << (2 * p));
        const bool valid = (s < 387) && (ps >= 0);
        float d = 0.f;
        if (valid) { float kk[8]; unpack8(*(const u32x4*)(kbase + (size_t)ps * NZ), kk);
#pragma unroll
            for (int e = 0; e < 8; ++e) d += q[e] * kk[e]; }
        d += __shfl_xor(d, 1); d += __shfl_xor(d, 2); d += __shfl_xor(d, 4);
        const float lg = valid ? d * 0.125f + W.BIAS[h * 388 + (valid ? s : 0)] : -1.0e30f;
        if (dg == 0) PL[s] = lg;
        m = fmaxf(m, lg);
    }
    m = wave_max(m);
    LDS_WAIT(); asm volatile("" ::: "memory");
    float sum = 0.f;
#pragma unroll
    for (int r = 0; r < 7; ++r) { const int s = r * 64 + lane; if (s < 392) { const float pr = __expf(PL[s] - m); PL[s] = pr; sum += pr; } }
    sum = wave_sum(sum);
    LDS_WAIT(); asm volatile("" ::: "memory");
    float o[8];
#pragma unroll
    for (int e = 0; e < 8; ++e) o[e] = 0.f;
#pragma unroll 7
    for (int i = 0; i < 49; ++i) {
        const int s = i * 8 + sg; const int p = (s >= 258) ? 2 : ((s >= 129) ? 1 : 0); const int jj = s - 129 * p; const int ps = t - (jj << (2 * p));
        const bool valid = (s < 387) && (ps >= 0);
        if (valid) { const float pr = PL[s]; float vv[8]; unpack8(*(const u32x4*)(vbase + (size_t)ps * NZ), vv);
#pragma unroll
            for (int e = 0; e < 8; ++e) o[e] += pr * vv[e]; }
    }
    const float inv = 1.0f / sum;
#pragma unroll
    for (int e = 0; e < 8; ++e) { float v = o[e]; v += __shfl_xor(v, 8); v += __shfl_xor(v, 16); v += __shfl_xor(v, 32); o[e] = v * inv; }
    if (sg == 0) { u32x4 w; w.x = pk2(o[0], o[1]); w.y = pk2(o[2], o[3]); w.z = pk2(o[4], o[5]); w.w = pk2(o[6], o[7]); *(u32x4*)(W.Y + (size_t)t * DM + 256 + h * 64 + dg * 8) = w; }
    LDS_WAIT(); asm volatile("" ::: "memory");
}
__device__ __forceinline__ void attn_sample_part(const LayerP& L, const WsP& W, float* PART, int si, int lane) {
    asm volatile("" : "+v"(lane));
    const int chunk = si & 7, bh = si >> 3, b = bh >> 2, h = bh & 3, sg = lane >> 4, dg = lane & 15;
    const size_t zrow = (size_t)(TP + b) * NZ;
    float q[4];
    { const u32x2 w = *(const u32x2*)(W.Z + zrow + C_BQ + h * 64 + dg * 4); q[0] = bflo(w.x); q[1] = bfhi(w.x); q[2] = bflo(w.y); q[3] = bfhi(w.y); }
    const float* ckb = L.ck + (size_t)b * 2048 * 256 + h * 64 + dg * 4; const float* cvb = L.cv + (size_t)b * 2048 * 256 + h * 64 + dg * 4;
    float lg[13]; float m = -3.0e38f;
#pragma unroll
    for (int i = 0; i < 13; ++i) {
        const int sl = i * 4 + sg, s = chunk * 49 + sl; const bool valid = (sl < 49) && (s < 387);
        const int p = (s >= 258) ? 2 : ((s >= 129) ? 1 : 0); const int jj = s - 129 * p; const int idx = 2048 - (jj << (2 * p));
        float d = 0.f;
        if (valid) {
            f32x4 kk;
            if (idx == 2048) { const u32x2 w = *(const u32x2*)(W.Z + zrow + C_BK + h * 64 + dg * 4); kk = (f32x4){bflo(w.x), bfhi(w.x), bflo(w.y), bfhi(w.y)}; }
            else kk = *(const f32x4*)(ckb + (size_t)idx * 256);
            d = (q[0] * kk.x + q[1] * kk.y) + (q[2] * kk.z + q[3] * kk.w);
        }
        d += __shfl_xor(d, 1); d += __shfl_xor(d, 2); d += __shfl_xor(d, 4); d += __shfl_xor(d, 8);
        lg[i] = valid ? d * 0.125f + W.BIAS[h * 388 + (valid ? s : 0)] : -1.0e30f;
        m = fmaxf(m, lg[i]);
    }
    m = fmaxf(m, __shfl_xor(m, 16)); m = fmaxf(m, __shfl_xor(m, 32));
    float o[4] = {0.f, 0.f, 0.f, 0.f}; float sum = 0.f;
#pragma unroll
    for (int i = 0; i < 13; ++i) {
        const int sl = i * 4 + sg, s = chunk * 49 + sl; const bool valid = (sl < 49) && (s < 387);
        const int p = (s >= 258) ? 2 : ((s >= 129) ? 1 : 0); const int jj = s - 129 * p; const int idx = 2048 - (jj << (2 * p));
        if (valid) {
            const float pr = __expf(lg[i] - m); sum += pr;
            f32x4 vv;
            if (idx == 2048) { const u32x2 w = *(const u32x2*)(W.Z + zrow + C_BV + h * 64 + dg * 4); vv = (f32x4){bflo(w.x), bfhi(w.x), bflo(w.y), bfhi(w.y)}; }
            else vv = *(const f32x4*)(cvb + (size_t)idx * 256);
            o[0] += pr * vv.x; o[1] += pr * vv.y; o[2] += pr * vv.z; o[3] += pr * vv.w;
        }
    }
    sum += __shfl_xor(sum, 16); sum += __shfl_xor(sum, 32);
#pragma unroll
    for (int e = 0; e < 4; ++e) { o[e] += __shfl_xor(o[e], 16); o[e] += __shfl_xor(o[e], 32); }
    float* pp = PART + (size_t)si * 72;
    if (sg == 0) *(f32x4*)(pp + dg * 4) = (f32x4){o[0], o[1], o[2], o[3]};
    if (lane == 0) { pp[64] = m; pp[65] = sum; }
}
__device__ __forceinline__ void attn_sample_combine(const WsP& W, const float* PART, int bh, int lane) {
    asm volatile("" : "+v"(lane));
    const float* pp = PART + (size_t)bh * 8 * 72;
    float mc[8], M = -3.0e38f;
#pragma unroll
    for (int c = 0; c < 8; ++c) { mc[c] = pp[c * 72 + 64]; M = fmaxf(M, mc[c]); }
    float S = 0.f, o = 0.f;
#pragma unroll
    for (int c = 0; c < 8; ++c) { const float f = __expf(mc[c] - M); S += pp[c * 72 + 65] * f; o += pp[c * 72 + lane] * f; }
    const int b = bh >> 2, h = bh & 3;
    W.Y[(size_t)(TP + b) * DM + 256 + h * 64 + lane] = (bf16_t)f2bf(o / S);
}

__device__ __forceinline__ void sample_mixers(LAS unsigned char* lds, int b, const LayerP& L, const WsP& W, float* out, int tid) {
    asm volatile("" : "+v"(tid));
    LAS float* US = (LAS float*)lds;
    LAS float* PS = US + 256;
    LAS float* EG = PS + 256;
    LAS float* QS = EG + 128;
    LAS float* KS = QS + 128;
    LAS float* VV = KS + 128;
    LAS float* OP = VV + 256;
    const int row = TP + b, lb = b;
    const bf16_t* zr = W.Z + (size_t)row * NZ;
    const int l = L.l;
    if (tid < 256) {
        const int ch = tid;
        const float h0 = L.slc[((size_t)lb * 3 + 0) * 256 + ch], h1 = L.slc[((size_t)lb * 3 + 1) * 256 + ch], h2 = L.slc[((size_t)lb * 3 + 2) * 256 + ch], a0 = bf2f(zr[C_AU + ch]);
        US[ch] = L.conv_b[ch] + L.conv_w[ch] * h0 + L.conv_w[256 + ch] * h1 + L.conv_w[512 + ch] * h2 + L.conv_w[768 + ch] * a0;
        float* o = out + O_SC + ((size_t)(l * NB + b) * 3) * 256 + ch; o[0] = h1; o[256] = h2; o[512] = a0;
        out[O_SK + (size_t)(l * NB + b) * 256 + ch] = bf2f(zr[C_BK + ch]);
        out[O_SV + (size_t)(l * NB + b) * 256 + ch] = bf2f(zr[C_BV + ch]);
    } else {
        const int ch = tid - 256, g = ch >> 6, w = 2 << g;
        const float* hp = L.spool + (size_t)lb * 15 * 256 + ch; const float cu = bf2f(zr[C_CU + ch]);
        float s = cu;
#pragma unroll 1
        for (int i = 1; i < w; ++i) s += hp[(15 - i) * 256];
        PS[ch] = s / (float)w - cu;
        float* o = out + O_SP + (size_t)(l * NB + b) * 15 * 256 + ch;
#pragma unroll 2
        for (int r = 0; r < 14; ++r) o[r * 256] = hp[(r + 1) * 256];
        o[14 * 256] = cu;
    }
    if (tid < 128) {
        const int n = tid; float a = L.gla_b[n]; const float* d = W.DLR + (size_t)row * 16;
#pragma unroll
        for (int jj = 0; jj < 16; ++jj) a += d[jj] * L.w_lr[jj * 128 + n];
        EG[n] = __expf(logsigmoidf_(a) * (1.0f / 16.0f)); QS[n] = bf2f(zr[C_DQ + n]) * 0.17677669529663687f; KS[n] = bf2f(zr[C_DK + n]);
    } else if (tid < 384) { VV[tid - 128] = bf2f(zr[C_DV + tid - 128]); }
    __syncthreads();
    if (tid < 256) {
        const int ch = tid, h = ch >> 6, j = ch & 63; float r = 0.f, gi = 0.f;
#pragma unroll 16
        for (int i = 0; i < 64; ++i) { const float uu = US[h * 64 + i]; r += uu * L.wa[h * 4096 + i * 64 + j]; gi += uu * L.wx[h * 4096 + i * 64 + j]; }
        const float rr = sigmoidf_(r + L.ba[ch]), gg = sigmoidf_(gi + L.bx[ch]), la = -8.0f * log1pf(__expf(-L.lam[ch])) * rr, a = __expf(la);
        const float hn = a * L.slh[(size_t)lb * 256 + ch] + sqrtf(-expm1f(2.0f * la)) * (gg * US[ch]);
        out[O_SH + (size_t)(l * NB + b) * 256 + ch] = hn;
        W.Y[(size_t)row * DM + ch] = (bf16_t)f2bf(hn * gelu_tanh(bf2f(zr[C_AG + ch])));
    } else {
        const int d = tid - 256, g = d >> 6; float a = 0.f;
#pragma unroll 16
        for (int c = 0; c < 64; ++c) a += PS[g * 64 + c] * L.pool_w[g * 4096 + c * 64 + (d & 63)];
        W.Y[(size_t)row * DM + 512 + d] = (bf16_t)f2bf(a * L.pool_s[d]);
    }
    {
        const int dv = tid & 63, wv = tid >> 6;
        float po[4] = {0.f, 0.f, 0.f, 0.f};
#pragma unroll
        for (int k = 0; k < 16; ++k) { const int idx = tid + NT * k, hh = idx >> 11, dk = (idx >> 6) & 31;
            const float s0 = L.sgla[(size_t)lb * 8192 + idx]; const float sn = EG[hh * 32 + dk] * s0 + KS[hh * 32 + dk] * VV[hh * 64 + dv];
            out[O_SG + (size_t)(l * NB + b) * 8192 + idx] = sn; po[k >> 2] += QS[hh * 32 + dk] * sn; }
#pragma unroll
        for (int hh = 0; hh < 4; ++hh) OP[wv * 256 + hh * 64 + dv] = po[hh];
    }
    __syncthreads();
    if (tid < 256) {
        float o = 0.f;
#pragma unroll
        for (int wv = 0; wv < 8; ++wv) o += OP[wv * 256 + tid];
        const float ss = wave_sum(o * o);
        const float y = o * rsqrtf(ss * (1.0f / 64.0f) + EPS) * L.gla_n[tid] * siluf_(bf2f(zr[C_DR + tid]));
        W.Y[(size_t)row * DM + 768 + tid] = (bf16_t)f2bf(y);
    }
    __syncthreads();
}

__device__ __forceinline__ void gla_scan_item(LAS unsigned char* lds, int it, const LayerP& L, const WsP& W, float* out, int tid) {
    asm volatile("" : "+v"(tid));
    LAS float* SA = (LAS float*)lds; LAS float* SS = SA + 16;
    const int h = it >> 6, dk = (it >> 1) & 31, dv0 = (it & 1) * 32, cgp = tid >> 5, e = tid & 31;
    float d[16], s[16];
#pragma unroll
    for (int i = 0; i < 16; ++i) { const int c = cgp * 16 + i; d[i] = W.GDEC[c * 128 + h * 32 + dk]; s[i] = W.GDS[((size_t)(c * 4 + h) * 32 + dk) * 64 + dv0 + e]; }
    float A = 1.f, S = 0.f;
#pragma unroll
    for (int i = 0; i < 16; ++i) { S = d[i] * S + s[i]; A *= d[i]; }
    if (e == 0) SA[cgp] = A;
    SS[cgp * 32 + e] = S;
    __syncthreads();
    float Sin = 0.f;
    for (int jg = 0; jg < cgp; ++jg) Sin = SA[jg] * Sin + SS[jg * 32 + e];
    S = Sin;
#pragma unroll
    for (int i = 0; i < 16; ++i) { const int c = cgp * 16 + i; W.GDS[((size_t)(c * 4 + h) * 32 + dk) * 64 + dv0 + e] = S; S = d[i] * S + s[i]; }
    if (cgp == 15) out[O_PG + (size_t)L.l * 8192 + (h * 32 + dk) * 64 + dv0 + e] = S;
    __syncthreads();
}
__device__ __forceinline__ void lru_scan_item(LAS unsigned char* lds, int it, const LayerP& L, const WsP& W, float* out, int tid) {
    asm volatile("" : "+v"(tid));
    LAS float* LA_ = (LAS float*)lds; LAS float* LH_ = LA_ + 512;
    const int e = tid & 15, sg = tid >> 4, ch = it * 16 + e;
    float a[16], hh[16];
#pragma unroll
    for (int i = 0; i < 16; ++i) { const int seg = sg * 16 + i; a[i] = W.LA[seg * 256 + ch]; hh[i] = W.LH[seg * 256 + ch]; }
    float A = 1.f, H = 0.f;
#pragma unroll
    for (int i = 0; i < 16; ++i) { H = a[i] * H + hh[i]; A *= a[i]; }
    LA_[sg * 16 + e] = A; LH_[sg * 16 + e] = H;
    __syncthreads();
    float Hin = 0.f;
    for (int jg = 0; jg < sg; ++jg) Hin = LA_[jg * 16 + e] * Hin + LH_[jg * 16 + e];
    H = Hin;
#pragma unroll
    for (int i = 0; i < 16; ++i) { const int seg = sg * 16 + i; W.HIN[seg * 256 + ch] = H; H = a[i] * H + hh[i]; }
    if (sg == 31) out[O_PH + (size_t)L.l * 256 + ch] = H;
    __syncthreads();
}

__device__ __forceinline__ void lru_final(int tile, const LayerP& L, const WsP& W, int tid) {
    asm volatile("" : "+v"(tid));
    const int ch = tid & 255, half = tid >> 8, seg = tile * 2 + half, t0 = tile * 64 + half * 32;
    const float hin = W.HIN[seg * 256 + ch];
#pragma unroll 4
    for (int tok = 0; tok < 32; ++tok) { const size_t t = (size_t)(t0 + tok);
        const float hv = W.HLOC[t * 256 + ch] + W.PCUM[t * 256 + ch] * hin;
        W.Y[t * DM + ch] = (bf16_t)f2bf(hv * gelu_tanh(bf2f(W.Z[t * NZ + C_AG + ch]))); }
}
__device__ __forceinline__ void gla_final(LAS unsigned char* lds, int c, const LayerP& L, const WsP& W, int tid) {
    asm volatile("" : "+v"(tid));
    LAS float* QB = (LAS float*)lds;
    LAS float* KB = QB + 64 * 33;
    LAS float* VS = KB + 64 * 33;
    LAS float* SS = VS + 4096;
    LAS float* ATT = SS + 2048;
    const int t0 = c * 64, lane = tid & 63, wv = tid >> 6;
    for (int h = 0; h < 4; ++h) {
        for (int idx = tid; idx < 2048; idx += NT) { const int tok = idx >> 5, d = idx & 31; const size_t t = (size_t)(t0 + tok);
            const float bb = W.GB[t * 128 + h * 32 + d];
            QB[tok * 33 + d] = bf2f(W.Z[t * NZ + C_DQ + h * 32 + d]) * 0.17677669529663687f * __expf(bb);
            KB[tok * 33 + d] = bf2f(W.Z[t * NZ + C_DK + h * 32 + d]) * __expf(-bb);
            SS[idx] = W.GDS[((size_t)(c * 4 + h) * 32) * 64 + idx]; }
        for (int idx = tid; idx < 4096; idx += NT) { const int tok = idx >> 6, v = idx & 63; VS[idx] = bf2f(W.Z[(size_t)(t0 + tok) * NZ + C_DV + h * 64 + v]); }
        __syncthreads();
#pragma unroll
        for (int k = 0; k < 8; ++k) { const int i = wv + 8 * k, jt = lane; float a = 0.f;
            if (jt <= i) {
#pragma unroll
                for (int d = 0; d < 32; ++d) a += QB[i * 33 + d] * KB[jt * 33 + d]; }
            ATT[i * 65 + jt] = a; }
        __syncthreads();
#pragma unroll
        for (int k = 0; k < 8; ++k) { const int i = wv + 8 * k, v = lane; float o = 0.f;
            for (int jt = 0; jt <= i; ++jt) o += ATT[i * 65 + jt] * VS[jt * 64 + v];
#pragma unroll
            for (int d = 0; d < 32; ++d) o += QB[i * 33 + d] * SS[d * 64 + v];
            const float ss = wave_sum(o * o); const size_t t = (size_t)(t0 + i);
            const float y = o * rsqrtf(ss * (1.0f / 64.0f) + EPS) * L.gla_n[h * 64 + v] * siluf_(bf2f(W.Z[t * NZ + C_DR + h * 64 + v]));
            W.Y[t * DM + 768 + h * 64 + v] = (bf16_t)f2bf(y); }
        __syncthreads();
    }
}

typedef short bf16x8s __attribute__((ext_vector_type(8)));
typedef float f32x16 __attribute__((ext_vector_type(16)));
template <int MODE, int K>
__device__ __forceinline__ void skinny_unit(LAS unsigned char* lds, const bf16_t* A, const bf16_t* Bt, int n0, void* O, int ldo, const float* rscale, int tid) {
    asm volatile("" : "+v"(tid));
    const int lane = tid & 63, wave = tid >> 6, r = lane & 31, hh = lane >> 5;
    constexpr int KW = K / 8, STEPS = KW / 16;
    const bf16_t* ap = A + (size_t)(TP + r) * K + wave * KW + 8 * hh;
    const bf16_t* bp = Bt + (size_t)(n0 + r) * K + wave * KW + 8 * hh;
    f32x16 acc;
#pragma unroll
    for (int e = 0; e < 16; ++e) acc[e] = 0.f;
#pragma unroll 8
    for (int st = 0; st < STEPS; ++st) { const bf16x8s a = *(const bf16x8s*)(ap + st * 16); const bf16x8s b = *(const bf16x8s*)(bp + st * 16); acc = __builtin_amdgcn_mfma_f32_32x32x16_bf16(a, b, acc, 0, 0, 0); }
    LAS float* RED = (LAS float*)lds;
#pragma unroll
    for (int e = 0; e < 16; ++e) RED[(wave * 16 + e) * 64 + lane] = acc[e];
    __syncthreads();
#pragma unroll
    for (int k = 0; k < 2; ++k) { const int reg = wave * 2 + k; float v = 0.f;
#pragma unroll
        for (int w = 0; w < 8; ++w) v += RED[(w * 16 + reg) * 64 + lane];
        const int row = TP + (reg & 3) + 8 * (reg >> 2) + 4 * hh, col = n0 + r;
        if (MODE == 2) ((float*)O)[(size_t)row * ldo + col] = v;
        else { float x = v * rscale[row]; if (MODE == 1) { x = fmaxf(x, 0.f); x = x * x; } ((bf16_t*)O)[(size_t)row * ldo + col] = (bf16_t)f2bf(x); } }
    __syncthreads();
}

constexpr int PT_OFF = 131072 + 1024;
typedef volatile LAS unsigned long long* PtrTab;
__device__ __forceinline__ unsigned long long pt_ld(PtrTab PT, int i) { const unsigned long long v = PT[i]; const unsigned lo = __builtin_amdgcn_readfirstlane((unsigned)v), hi = __builtin_amdgcn_readfirstlane((unsigned)(v >> 32)); return ((unsigned long long)hi << 32) | lo; }
#define IN_(i) ((const float*)pt_ld(PT, (i)))
#define FRESH_IDS() int tid = threadIdx.x; asm volatile("" : "+v"(tid)); const int lane = tid & 63; const int wave = __builtin_amdgcn_readfirstlane(tid >> 6); const int gw = bid * NWAVES + wave, NGW = G * NWAVES; (void)lane; (void)gw; (void)NGW; \
    unsigned char* ws = (unsigned char*)pt_ld(PT, 30); float* out = (float*)pt_ld(PT, 29); (void)out
__device__ __forceinline__ WsP make_w(unsigned char* ws) {
    WsP W;
    W.XB = (bf16_t*)(ws + WS_XB); W.Z = (bf16_t*)(ws + WS_Z); W.Y = (bf16_t*)(ws + WS_Y); W.U = (bf16_t*)(ws + WS_U); W.MIX = (float*)(ws + WS_MIX);
    W.RSTD = (float*)(ws + WS_RSTD); W.DLR = (float*)(ws + WS_DLR); W.HLOC = (float*)(ws + WS_HLOC); W.PCUM = (float*)(ws + WS_PCUM);
    W.LA = (float*)(ws + WS_LAGG); W.LH = W.LA + 512 * 256; W.HIN = W.LH + 512 * 256;
    W.GDS = (float*)(ws + WS_GDS); W.GDEC = (float*)(ws + WS_GDEC); W.GB = (float*)(ws + WS_GB); W.BIAS = (float*)(ws + WS_BIAS);
    return W;
}
__device__ __forceinline__ LayerP make_l(PtrTab PT, int l) {
    LayerP L;
    L.l = l;
    L.conv_w = IN_(I_CONVW) + l * 1024; L.conv_b = IN_(I_CONVB) + l * 256; L.wa = IN_(I_WA) + l * 16384; L.ba = IN_(I_BA) + l * 256;
    L.wx = IN_(I_WX) + l * 16384; L.bx = IN_(I_BX) + l * 256; L.lam = IN_(I_LAM) + l * 256; L.pool_w = IN_(I_POOLW) + l * 16384; L.pool_s = IN_(I_POOLS) + l * 256;
    L.w_lr = IN_(I_WLR) + l * 2048; L.gla_b = IN_(I_GLAB) + l * 128; L.gla_n = IN_(I_GLAN) + l * 256;
    L.slh = IN_(I_SLH) + (size_t)l * NB * 256; L.slc = IN_(I_SLC) + (size_t)l * NB * 768; L.ck = IN_(I_CK) + (size_t)l * NB * 2048 * 256; L.cv = IN_(I_CV) + (size_t)l * NB * 2048 * 256;
    L.spool = IN_(I_SPOOL) + (size_t)l * NB * 3840; L.sgla = IN_(I_SGLA) + (size_t)l * NB * 8192;
    return L;
}

__global__ void __launch_bounds__(NT, 2) mk_fwd(Args args) {
    extern __shared__ __attribute__((aligned(16))) unsigned char lds_raw[];
    LAS unsigned char* lds = (LAS unsigned char*)lds_raw;
    cg::grid_group grid = cg::this_grid();
    const int G = gridDim.x, bid = blockIdx.x;
    volatile LAS unsigned* MISC = (volatile LAS unsigned*)(lds + MISC_OFF);
    PtrTab PT = (PtrTab)(lds + PT_OFF);
    if (threadIdx.x < 32) MISC[threadIdx.x] = 0u;
    if (threadIdx.x == 64) {
        PT[0] = (unsigned long long)args.in[0]; PT[1] = (unsigned long long)args.in[1]; PT[2] = (unsigned long long)args.in[2]; PT[3] = (unsigned long long)args.in[3];
        PT[4] = (unsigned long long)args.in[4]; PT[5] = (unsigned long long)args.in[5]; PT[6] = (unsigned long long)args.in[6]; PT[7] = (unsigned long long)args.in[7];
        PT[8] = (unsigned long long)args.in[8]; PT[9] = (unsigned long long)args.in[9]; PT[10] = (unsigned long long)args.in[10]; PT[11] = (unsigned long long)args.in[11];
        PT[12] = (unsigned long long)args.in[12]; PT[13] = (unsigned long long)args.in[13]; PT[14] = (unsigned long long)args.in[14]; PT[15] = (unsigned long long)args.in[15];
        PT[16] = (unsigned long long)args.in[16]; PT[17] = (unsigned long long)args.in[17]; PT[18] = (unsigned long long)args.in[18]; PT[19] = (unsigned long long)args.in[19];
        PT[20] = (unsigned long long)args.in[20]; PT[21] = (unsigned long long)args.in[21]; PT[22] = (unsigned long long)args.in[22]; PT[23] = (unsigned long long)args.in[23];
        PT[24] = (unsigned long long)args.in[24]; PT[25] = (unsigned long long)args.in[25]; PT[26] = (unsigned long long)args.in[26]; PT[27] = (unsigned long long)args.in[27];
        PT[28] = (unsigned long long)args.in[28]; PT[29] = (unsigned long long)args.out; PT[30] = (unsigned long long)args.ws;
    }
    __syncthreads();
    XcdBarrier bar = xcd_barrier_post((unsigned*)(args.ws + WS_CTL) + CW_BAR, MISC + 8);

    {
        FRESH_IDS(); const WsP W = make_w(ws);
        LAS float* scr = (LAS float*)(lds + wave * 16384);
        constexpr int I_IN = 16 * (NZ / 32), I_OUT = 16 * 32, I_UP = 16 * (FF / 32), I_DN = 64 * 32, I_L = I_IN + I_OUT + I_UP + I_DN;
        for (int it = gw; it < 2 * I_L; it += NGW) {
            const int l = it / I_L; int r = it % I_L;
            if (r < I_IN) { p0_transpose_item(IN_(I_WIN) + (size_t)l * DM * NIN, NIN, DM, NZ, IN_(I_NPREMIX) + l * DM, (bf16_t*)(ws + WS_WIN) + (size_t)l * NZ * DM, scr, r, lane); continue; } r -= I_IN;
            if (r < I_OUT) { p0_transpose_item(IN_(I_WOUT) + (size_t)l * DM * DM, DM, DM, DM, nullptr, (bf16_t*)(ws + WS_WOUT) + (size_t)l * DM * DM, scr, r, lane); continue; } r -= I_OUT;
            if (r < I_UP) { p0_transpose_item(IN_(I_WUP) + (size_t)l * DM * FF, FF, DM, FF, IN_(I_NPREMLP) + l * DM, (bf16_t*)(ws + WS_WUP) + (size_t)l * FF * DM, scr, r, lane); continue; } r -= I_UP;
            p0_transpose_item(IN_(I_WDOWN) + (size_t)l * FF * DM, DM, FF, DM, nullptr, (bf16_t*)(ws + WS_WDN) + (size_t)l * DM * FF, scr, r, lane);
        }
        { const float* relb = IN_(I_RELB); for (int i = bid * NT + tid; i < 4 * 388; i += G * NT) { const int h = i / 388, s = i % 388; W.BIAS[i] = (s < 387) ? relb[BUCKET[s] * 4 + h] : 0.f; } }
        __syncthreads();
        rowpass<false, true>(lds, IN_(I_XP), IN_(I_XS), nullptr, nullptr, nullptr, IN_(I_NPREMIX), IN_(I_WIN), W.XB, W.RSTD, W.DLR, gw, NGW, tid);
    }
    xcd_barrier(bar);

#pragma unroll 1
    for (int l = 0; l < 2; ++l) {
        {
            FRESH_IDS(); const WsP W = make_w(ws);
            pg8::Gemm g{W.XB, (const bf16_t*)(ws + WS_WIN) + (size_t)l * NZ * DM, TP, NZ, DM}; pg8::StaticOrder S; S.init(TP, NZ, G, bid);
            pg8::EpiScaleBf16<0> E{W.Z, NZ, W.RSTD};
            for (int u = bid; u < NZ / 32; u += G) skinny_unit<0, DM>(lds, W.XB, (const bf16_t*)(ws + WS_WIN) + (size_t)l * NZ * DM, u * 32, W.Z, NZ, W.RSTD, tid);
#ifndef SK_GEMM
            pg8::gemm_phase<pg8::EpiScaleBf16<0>, pg8::StaticOrder, true, true>(lds, g, S, E);
#endif
        }
        xcd_barrier(bar);

        {
            FRESH_IDS(); const WsP W = make_w(ws); const LayerP L = make_l(PT, l);
            for (int tile = bid; tile < 256; tile += G) {
#ifndef SK_LRUL
                lru_local(lds, tile, L, W, out, tid);
#endif
#ifndef SK_GLAL
                gla_local(lds, tile, L, W, tid);
#endif
#ifndef SK_POOL
                pool_tile(lds, tile, L, W, out, tid);
#endif
 }
#ifndef SK_SAMP
            for (int b = bid; b < NB; b += G) sample_mixers(lds, b, L, W, out, tid);
#endif
            for (int si = gw; si < NB * 4 * 8; si += NGW) attn_sample_part(L, W, (float*)(ws + WS_PART), si, lane);
#ifndef SK_ATTN
            for (int it = gw; it < TP * 4; it += NGW) attn_prompt_item((LAS float*)lds + wave * 400, W, it >> 2, it & 3, lane);
#endif
            for (int i = bid * NT + tid; i < 2 * 2048 * 256; i += G * NT) { const int which = i >> 19, r = (i >> 8) & 2047, c = i & 255;
                out[(which ? O_PV : O_PK) + (size_t)l * 524288 + r * 256 + c] = bf2f(W.Z[(size_t)(TP - 2048 + r) * NZ + (which ? C_BV : C_BK) + c]); }
        }
        xcd_barrier(bar);

        {
            FRESH_IDS(); const WsP W = make_w(ws); LayerP L; L.l = l;
#ifndef SK_SCAN
            for (int it = bid; it < 272; it += G) { if (it < 256) gla_scan_item(lds, it, L, W, out, tid); else lru_scan_item(lds, it - 256, L, W, out, tid); }
#endif
        }
        xcd_barrier(bar);

        {
            FRESH_IDS(); const WsP W = make_w(ws); const LayerP L = make_l(PT, l);
            for (int bh = gw; bh < NB * 4; bh += NGW) attn_sample_combine(W, (const float*)(ws + WS_PART), bh, lane);
            for (int tile = bid; tile < 256; tile += G) {
#ifndef SK_LRUF
                lru_final(tile, L, W, tid);
#endif
#ifndef SK_GLAF
                gla_final(lds, tile, L, W, tid);
#endif
 }
        }
        xcd_barrier(bar);

        {
            FRESH_IDS(); const WsP W = make_w(ws);
            pg8::Gemm g{W.Y, (const bf16_t*)(ws + WS_WOUT) + (size_t)l * DM * DM, TP, DM, DM}; pg8::StaticOrder S; S.init(TP, DM, G, bid);
            for (int u = bid; u < DM / 32; u += G) skinny_unit<2, DM>(lds, W.Y, (const bf16_t*)(ws + WS_WOUT) + (size_t)l * DM * DM, u * 32, W.MIX, DM, nullptr, tid);
            pg8::EpiF32 E{W.MIX, DM};
#ifndef SK_GEMM
            pg8::gemm_phase<pg8::EpiF32, pg8::StaticOrder, true, true>(lds, g, S, E);
#endif
        }
        xcd_barrier(bar);
        {
            FRESH_IDS(); const WsP W = make_w(ws);
            rowpass<true, false>(lds, l == 0 ? IN_(I_XP) : out + O_YP, l == 0 ? IN_(I_XS) : out + O_YS, out, W.MIX, IN_(I_NPOSTMIX) + l * DM, nullptr, nullptr, W.XB, W.RSTD, W.DLR, gw, NGW, tid);
        }
        xcd_barrier(bar);
        {
            FRESH_IDS(); const WsP W = make_w(ws);
            pg8::Gemm g{W.XB, (const bf16_t*)(ws + WS_WUP) + (size_t)l * FF * DM, TP, FF, DM}; pg8::StaticOrder S; S.init(TP, FF, G, bid);
            pg8::EpiScaleBf16<1> E{W.U, FF, W.RSTD};
            for (int u = bid; u < FF / 32; u += G) skinny_unit<1, DM>(lds, W.XB, (const bf16_t*)(ws + WS_WUP) + (size_t)l * FF * DM, u * 32, W.U, FF, W.RSTD, tid);
#ifndef SK_GEMM
            pg8::gemm_phase<pg8::EpiScaleBf16<1>, pg8::StaticOrder, true, true>(lds, g, S, E);
#endif
        }
        xcd_barrier(bar);
        {
            FRESH_IDS(); const WsP W = make_w(ws);
            pg8::Gemm g{W.U, (const bf16_t*)(ws + WS_WDN) + (size_t)l * DM * FF, TP, DM, FF}; pg8::StaticOrder S; S.init(TP, DM, G, bid);
            for (int u = bid; u < DM / 32; u += G) skinny_unit<2, FF>(lds, W.U, (const bf16_t*)(ws + WS_WDN) + (size_t)l * DM * FF, u * 32, W.MIX, DM, nullptr, tid);
            pg8::EpiF32 E{W.MIX, DM};
#ifndef SK_GEMM
            pg8::gemm_phase<pg8::EpiF32, pg8::StaticOrder, true, true>(lds, g, S, E);
#endif
        }
        xcd_barrier(bar);
        {
            FRESH_IDS(); const WsP W = make_w(ws);
#ifndef SK_ROWP
            if (l == 0) rowpass<true, true>(lds, out + O_YP, out + O_YS, out, W.MIX, IN_(I_NPOSTMLP) + l * DM, IN_(I_NPREMIX) + DM, IN_(I_WIN) + (size_t)DM * NIN, W.XB, W.RSTD, W.DLR, gw, NGW, tid);
            else        rowpass<true, false>(lds, out + O_YP, out + O_YS, out, W.MIX, IN_(I_NPOSTMLP) + l * DM, nullptr, nullptr, W.XB, W.RSTD, W.DLR, gw, NGW, tid);
#endif
        }
        if (l == 0) xcd_barrier(bar);
    }
    if (G == 0x7fffffff) grid.sync();
}

extern "C" void kernel_launch(void* const* d_in, const int* in_sizes, int n_in, void* d_out, int out_size, void* d_ws, size_t ws_size, hipStream_t stream) {
    static int grid = 0;
    if (grid == 0) {
        if (n_in != N_INPUTS || out_size != (int)O_END || ws_size < WS_END) { fprintf(stderr, "kernel_launch: unexpected sizes: n_in %d out %d ws %zu\n", n_in, out_size, ws_size); grid = -1; return; }
        int dev = 0, cus = 0, per_cu = 0;
        if (hipGetDevice(&dev) != hipSuccess || hipDeviceGetAttribute(&cus, hipDeviceAttributeMultiprocessorCount, dev) != hipSuccess) { grid = -1; return; }
        if (hipFuncSetAttribute((const void*)mk_fwd, hipFuncAttributeMaxDynamicSharedMemorySize, LDS_BYTES) != hipSuccess) { fprintf(stderr, "kernel_launch: hipFuncSetAttribute failed\n"); grid = -1; return; }
        if (hipOccupancyMaxActiveBlocksPerMultiprocessor(&per_cu, (const void*)mk_fwd, NT, LDS_BYTES) != hipSuccess || per_cu < 1) { fprintf(stderr, "kernel_launch: occupancy query says %d blocks per CU\n", per_cu); grid = -1; return; }
        grid = cus;
    }
    if (grid < 0) return;
    (void)hipMemsetAsync((char*)d_ws + WS_CTL, 0, CTL_ZERO_BYTES, stream);
    Args a{};
    for (int i = 0; i < N_INPUTS; ++i) a.in[i] = (const float*)d_in[i];
    a.out = (float*)d_out; a.ws = (unsigned char*)d_ws;
    void* kargs[] = {&a};
    hipError_t e = hipLaunchCooperativeKernel((const void*)mk_fwd, dim3(grid), dim3(NT), kargs, LDS_BYTES, stream);
    if (e != hipSuccess) fprintf(stderr, "cooperative launch failed: %s (grid %d)\n", hipGetErrorString(e), grid);
}
```

```cpp
#include <hip/hip_runtime.h>
#include <hip/hip_cooperative_groups.h>
#include <cstdio>
#include <cstdint>
namespace cg = cooperative_groups;
namespace pg8 {
#define PG8_LAS __attribute__((address_space(3)))
typedef unsigned short bf16_t;
typedef short bf16x8 __attribute__((ext_vector_type(8)));
typedef float f32x4 __attribute__((ext_vector_type(4)));
typedef unsigned u32x4 __attribute__((ext_vector_type(4)));
constexpr int BM = 256, BK = 64, HALF = 128, HTB = HALF * BK * 2  , STAGE_BYTES = 8 * HTB, NXCD = 8, WGM = 8;

__host__ __device__ __forceinline__ int lds_byte(int r, int c) { const int st = (r >> 4) * 2 + (c >> 5), rr = r & 15, cc = c & 31, ob = rr * 64 + cc * 2; return st * 1024 + (ob ^ (((ob >> 9) & 1) << 5)); }
__host__ __device__ __forceinline__ void stage_rc(int b, int& R, int& C) { const int st = b / 1024, sb = b % 1024, swz = sb ^ (((sb >> 9) & 1) << 5); R = (st >> 1) * 16 + swz / 64; C = (st & 1) * 32 + (swz % 64) / 2; }
__host__ __device__ __forceinline__ int perm32(int rho) { const int n = rho >> 4, i = rho & 15; return 8 * (i >> 2) + 4 * n + (i & 3); }

struct Unit { int pm, pn; };
struct Gemm { const bf16_t* A; const bf16_t* Bt; int M, N, K; };

struct StaticOrder {
    int nM, nN, nwg, G, c;
    __host__ __device__ void init(int M, int N, int G_, int c_) { nM = M / BM; nN = N / BM; nwg = nM * nN; G = G_; c = c_; }
    __host__ __device__ bool next(int i, Unit& u) const {
        const long L = (long)i * G + c; if (L >= nwg) return false;
        int wgid = (int)L; { const int q = nwg / NXCD, r = nwg % NXCD, xcd = wgid % NXCD, off = wgid / NXCD; wgid = (xcd < r ? xcd * (q + 1) : r * (q + 1) + (xcd - r) * q) + off; }
        const int nig = WGM * nN, gid = wgid / nig, fm = gid * WGM, gsz = (nM - fm) < WGM ? (nM - fm) : WGM;
        u.pm = fm + ((wgid % nig) % gsz); u.pn = (wgid % nig) / gsz; return true;
    }
    __device__ __forceinline__ void a_ready(const Unit&) const {}
    __device__ __forceinline__ void done(const Unit&) const {}
};

__device__ __forceinline__ unsigned cvt_pk_bf16(float lo, float hi) { unsigned r; asm volatile("v_cvt_pk_bf16_f32 %0, %1, %2" : "=v"(r) : "v"(lo), "v"(hi)); return r; }
template <int ACT> struct EpiScaleBf16 {
    static constexpr bool PERM = true, AFTER_DRAIN = false;
    bf16_t* O; int ldc; const float* rscale;
    __device__ __forceinline__ void operator()(const f32x4 (&acc)[2][2][4][2], const Unit& u, int wr, int wc, int fr, int fq) const {
        const int row0 = u.pm * BM + wr * 64 + fr; const int col0 = u.pn * BM + wc * 32 + 8 * fq;
#pragma unroll
        for (int ai = 0; ai < 2; ++ai)
#pragma unroll
            for (int m = 0; m < 4; ++m) { const int row = row0 + ai * HALF + m * 16; const float sc = rscale[row]; bf16_t* rowp = O + (size_t)row * ldc + col0;
#pragma unroll
                for (int bj = 0; bj < 2; ++bj) { f32x4 v0 = acc[ai][bj][m][0] * sc, v1 = acc[ai][bj][m][1] * sc;
                    if (ACT == 1) {
#pragma unroll
                        for (int e = 0; e < 4; ++e) { const float a = fmaxf(v0[e], 0.f), b = fmaxf(v1[e], 0.f); v0[e] = a * a; v1[e] = b * b; } }
                    u32x4 w; w.x = cvt_pk_bf16(v0[0], v0[1]); w.y = cvt_pk_bf16(v0[2], v0[3]); w.z = cvt_pk_bf16(v1[0], v1[1]); w.w = cvt_pk_bf16(v1[2], v1[3]);
                    *(u32x4*)(rowp + bj * HALF) = w; } }
    }
};
struct EpiF32 {
    static constexpr bool PERM = true, AFTER_DRAIN = false;
    float* O; int ldc;
    __device__ __forceinline__ void operator()(const f32x4 (&acc)[2][2][4][2], const Unit& u, int wr, int wc, int fr, int fq) const {
        const int row0 = u.pm * BM + wr * 64 + fr; const int col0 = u.pn * BM + wc * 32 + 8 * fq;
#pragma unroll
        for (int ai = 0; ai < 2; ++ai)
#pragma unroll
            for (int m = 0; m < 4; ++m) { float* rowp = O + (size_t)(row0 + ai * HALF + m * 16) * ldc + col0;
#pragma unroll
                for (int bj = 0; bj < 2; ++bj) { *(f32x4*)(rowp + bj * HALF) = acc[ai][bj][m][0]; *(f32x4*)(rowp + bj * HALF + 4) = acc[ai][bj][m][1]; } }
    }
};

template <class Epi, class Sched, bool ALIGN_EPI = false, bool SP2 = false>
__device__ __forceinline__ void gemm_phase(PG8_LAS unsigned char* lds, const Gemm g, const Sched& S, const Epi& E) {
    int tid_l = threadIdx.x; asm volatile("" : "+v"(tid_l));
    const int tid = tid_l, wid = __builtin_amdgcn_readfirstlane(tid >> 6), lane = tid & 63, wr = wid >> 2, wc = wid & 3, fr = lane & 15, fq = lane >> 4;
    const int K = g.K, nt = K / BK;
    unsigned voffA, voffB;
    { int R, C; stage_rc(tid * 16, R, C); const int Rb = Epi::PERM ? ((R & ~31) + perm32(R & 31)) : R;
        voffA = (unsigned)(R * K + C) * 2u; voffB = (unsigned)(Rb * K + C) * 2u; }
    const size_t rstep = (size_t)64 * K * 2;
    const size_t kstep = (size_t)(BK * 2);
    const size_t hstep = (size_t)HALF * K * 2;
    const size_t tstep = 2 * hstep;
    const unsigned ldsw = (unsigned)wid * 1024u;
    const int aoff = lds_byte(wr * 64 + fr, fq * 8), boff = lds_byte(wc * 32 + fr, fq * 8);
#define PG8_SA(b, h) (((b) * 2 + (h)) * HTB)
#define PG8_SB(b, h) ((4 + (b) * 2 + (h)) * HTB)
#define PG8_STAGE(bufoff, gbase, voff) do { _Pragma("unroll") for (int _i = 0; _i < 2; ++_i) \
        __builtin_amdgcn_global_load_lds((const unsigned*)((const char*)(gbase) + (size_t)_i * rstep + (voff)), (PG8_LAS unsigned*)(lds + (bufoff) + ldsw + _i * 8192), 16, 0, 0); } while (0)
#define PG8_LDA(dst, b, h) do { _Pragma("unroll") for (int m = 0; m < 4; ++m) _Pragma("unroll") for (int k = 0; k < 2; ++k) dst[m][k] = *(const PG8_LAS bf16x8*)(lds + PG8_SA(b, h) + aoff + m * 2048 + k * 1024); } while (0)
#define PG8_LDB(dst, b, h) do { _Pragma("unroll") for (int n = 0; n < 2; ++n) _Pragma("unroll") for (int k = 0; k < 2; ++k) dst[n][k] = *(const PG8_LAS bf16x8*)(lds + PG8_SB(b, h) + boff + n * 2048 + k * 1024); } while (0)
#define PG8_MMA(ai, bj, At, Bt) do { __builtin_amdgcn_s_setprio(1); _Pragma("unroll") for (int m = 0; m < 4; ++m) _Pragma("unroll") for (int n = 0; n < 2; ++n) _Pragma("unroll") for (int k = 0; k < 2; ++k) \
        acc[ai][bj][m][n] = __builtin_amdgcn_mfma_f32_16x16x32_bf16(Bt[n][k], At[m][k], acc[ai][bj][m][n], 0, 0, 0); __builtin_amdgcn_s_setprio(0); } while (0)
#define PG8_WAIT_V(n) asm volatile("s_waitcnt vmcnt(" #n ")" ::: "memory")
#define PG8_WAIT_L(n) asm volatile("s_waitcnt lgkmcnt(" #n ")" ::: "memory")
#define PG8_BAR __builtin_amdgcn_s_barrier()
#define PG8_SCHED __builtin_amdgcn_sched_barrier(0)
    Unit cur, nxt; int ui = 0;
    if (!S.next(0, cur)) return;
    f32x4 acc[2][2][4][2];
#pragma unroll
    for (int a = 0; a < 2; ++a)
#pragma unroll
        for (int b = 0; b < 2; ++b)
#pragma unroll
            for (int m = 0; m < 4; ++m)
#pragma unroll
                for (int n = 0; n < 2; ++n) acc[a][b][m][n] = (f32x4){0.f, 0.f, 0.f, 0.f};
    bf16x8 At[4][2], B0[2][2], B1[2][2];
    const char* cA = (const char*)g.A + (size_t)cur.pm * tstep; const char* cB = (const char*)g.Bt + (size_t)cur.pn * tstep;
    S.a_ready(cur);
    if constexpr (SP2) {
        PG8_STAGE(PG8_SB(0, 0), cB, voffB); PG8_STAGE(PG8_SB(0, 1), cB + hstep, voffB); PG8_STAGE(PG8_SA(0, 0), cA, voffA); PG8_STAGE(PG8_SA(0, 1), cA + hstep, voffA);
        if (wr == 1) PG8_BAR;
        PG8_WAIT_V(2); PG8_BAR;
        PG8_STAGE(PG8_SB(1, 0), cB + kstep, voffB); PG8_STAGE(PG8_SA(1, 0), cA + kstep, voffA); PG8_STAGE(PG8_SB(1, 1), cB + hstep + kstep, voffB);
        PG8_WAIT_V(6); PG8_BAR;
    } else {
        PG8_STAGE(PG8_SB(0, 0), cB, voffB); PG8_STAGE(PG8_SA(0, 0), cA, voffA); PG8_STAGE(PG8_SB(0, 1), cB + hstep, voffB); PG8_STAGE(PG8_SA(0, 1), cA + hstep, voffA);
        if (wr == 1) PG8_BAR;
        PG8_WAIT_V(4); PG8_BAR;
        PG8_STAGE(PG8_SB(1, 0), cB + kstep, voffB); PG8_STAGE(PG8_SA(1, 0), cA + kstep, voffA); PG8_STAGE(PG8_SB(1, 1), cB + hstep + kstep, voffB);
        PG8_WAIT_V(6); PG8_BAR;
    }
    for (;;) {
        const bool has_next = S.next(ui + 1, nxt);
        const char* nA = has_next ? (const char*)g.A + (size_t)nxt.pm * tstep : cA; const char* nB = has_next ? (const char*)g.Bt + (size_t)nxt.pn * tstep : cB;
        for (int t = 0; t < nt; t += 2) {
            const bool last = (t == nt - 2);
            const char* a1 = cA + (size_t)(t + 1) * kstep;
            const char* a2 = last ? nA : cA + (size_t)(t + 2) * kstep; const char* b2 = last ? nB : cB + (size_t)(t + 2) * kstep;
            const char* a3 = a2 + kstep; const char* b3 = b2 + kstep;
            if (last && has_next) S.a_ready(nxt);
            if constexpr (SP2) {
            PG8_LDB(B0, 0, 0); PG8_LDB(B1, 0, 1); PG8_SCHED; PG8_LDA(At, 0, 0); PG8_STAGE(PG8_SA(1, 1), a1 + hstep, voffA);
            PG8_WAIT_V(8); PG8_WAIT_L(0); PG8_BAR; PG8_MMA(0, 0, At, B0); PG8_MMA(0, 1, At, B1); PG8_BAR; PG8_SCHED;
            PG8_LDA(At, 0, 1); PG8_STAGE(PG8_SB(0, 0), b2, voffB); PG8_STAGE(PG8_SB(0, 1), b2 + hstep, voffB); PG8_STAGE(PG8_SA(0, 0), a2, voffA);
            PG8_WAIT_V(8); PG8_WAIT_L(0); PG8_BAR; PG8_MMA(1, 0, At, B0); PG8_MMA(1, 1, At, B1); PG8_BAR; PG8_SCHED;
            PG8_LDB(B0, 1, 0); PG8_LDB(B1, 1, 1); PG8_SCHED; PG8_LDA(At, 1, 0); PG8_STAGE(PG8_SA(0, 1), a2 + hstep, voffA);
            PG8_WAIT_V(8); PG8_WAIT_L(0); PG8_BAR; PG8_MMA(0, 0, At, B0); PG8_MMA(0, 1, At, B1); PG8_BAR; PG8_SCHED;
            PG8_LDA(At, 1, 1); PG8_STAGE(PG8_SB(1, 0), b3, voffB); PG8_STAGE(PG8_SB(1, 1), b3 + hstep, voffB); PG8_STAGE(PG8_SA(1, 0), a3, voffA);
            PG8_WAIT_V(8); PG8_WAIT_L(0); PG8_BAR; PG8_MMA(1, 0, At, B0); PG8_MMA(1, 1, At, B1); PG8_BAR; PG8_SCHED;
            } else {
            PG8_LDB(B0, 0, 0); PG8_SCHED; PG8_LDA(At, 0, 0); PG8_STAGE(PG8_SA(1, 1), a1 + hstep, voffA);
            PG8_WAIT_L(8); PG8_BAR; PG8_WAIT_L(0); PG8_MMA(0, 0, At, B0); PG8_BAR; PG8_SCHED;
            PG8_LDB(B1, 0, 1); PG8_STAGE(PG8_SB(0, 0), b2, voffB);
            PG8_BAR; PG8_WAIT_L(0); PG8_MMA(0, 1, At, B1); PG8_BAR;
            PG8_LDA(At, 0, 1); PG8_STAGE(PG8_SA(0, 0), a2, voffA);
            PG8_BAR; PG8_WAIT_L(0); PG8_MMA(1, 0, At, B0); PG8_BAR; PG8_SCHED;
            PG8_STAGE(PG8_SB(0, 1), b2 + hstep, voffB);
            PG8_WAIT_V(6); PG8_BAR; PG8_MMA(1, 1, At, B1); PG8_BAR;
            PG8_LDB(B0, 1, 0); PG8_SCHED; PG8_LDA(At, 1, 0); PG8_STAGE(PG8_SA(0, 1), a2 + hstep, voffA);
            PG8_WAIT_L(8); PG8_BAR; PG8_WAIT_L(0); PG8_MMA(0, 0, At, B0); PG8_BAR; PG8_SCHED;
            PG8_LDB(B1, 1, 1); PG8_STAGE(PG8_SB(1, 0), b3, voffB);
            PG8_BAR; PG8_WAIT_L(0); PG8_MMA(0, 1, At, B1); PG8_BAR;
            PG8_LDA(At, 1, 1); PG8_STAGE(PG8_SA(1, 0), a3, voffA);
            PG8_BAR; PG8_WAIT_L(0); PG8_MMA(1, 0, At, B0); PG8_BAR; PG8_SCHED;
            PG8_STAGE(PG8_SB(1, 1), b3 + hstep, voffB);
            PG8_WAIT_V(6); PG8_BAR; PG8_MMA(1, 1, At, B1); PG8_BAR;
            }
        }
        if constexpr (ALIGN_EPI) { if (wr == 0) PG8_BAR; }
        if constexpr (!Epi::AFTER_DRAIN) { E(acc, cur, wr, wc, fr, fq); S.done(cur); }
        if (!has_next) break;
#pragma unroll
        for (int a = 0; a < 2; ++a)
#pragma unroll
            for (int b = 0; b < 2; ++b)
#pragma unroll
                for (int m = 0; m < 4; ++m)
#pragma unroll
                    for (int n = 0; n < 2; ++n) acc[a][b][m][n] = (f32x4){0.f, 0.f, 0.f, 0.f};
        cur = nxt; cA = nA; cB = nB; ++ui;
        if constexpr (ALIGN_EPI) { if (wr == 1) PG8_BAR; }
    }
    PG8_WAIT_V(0);
    if constexpr (!ALIGN_EPI) { if (wr == 0) PG8_BAR; }
    PG8_BAR;
    if constexpr (Epi::AFTER_DRAIN) { E.fused(acc, cur, wr, wc, fr, fq, lds, wid, lane); S.done(cur); }
#undef PG8_SA
#undef PG8_SB
#undef PG8_STAGE
#undef PG8_LDA
#undef PG8_LDB
#undef PG8_MMA
#undef PG8_WAIT_V
#undef PG8_WAIT_L
#undef PG8_BAR
#undef PG8_SCHED
}
}

#define GAS __attribute__((address_space(1)))
#define LAS __attribute__((address_space(3)))
typedef unsigned short bf16_t;
typedef float f32x4 __attribute__((ext_vector_type(4)));
typedef unsigned u32x4 __attribute__((ext_vector_type(4)));
typedef unsigned u32x2 __attribute__((ext_vector_type(2)));

constexpr int NT = 512, NWAVES = 8;
constexpr int DM = 1024, TP = 16384, NB = 32, MROWS = 16640, NROWS = TP + NB, NZ = 2304, NIN = 2320, FF = 4096;
constexpr float EPS = 1e-6f;
constexpr int C_AU = 0, C_AG = 256, C_BQ = 512, C_BK = 768, C_BV = 1024, C_CU = 1280, C_DQ = 1536, C_DK = 1664, C_DV = 1792, C_DR = 2048;
enum { I_XP = 0, I_XS, I_SLH, I_SLC, I_CK, I_CV, I_SPOOL, I_SGLA, I_NPREMIX, I_NPOSTMIX, I_NPREMLP, I_NPOSTMLP, I_WIN, I_CONVW, I_CONVB, I_WA, I_BA, I_WX, I_BX, I_LAM, I_RELB, I_POOLW, I_POOLS, I_WLR, I_GLAB, I_GLAN, I_WOUT, I_WUP, I_WDOWN, N_INPUTS };
constexpr size_t O_YP = 0, O_YS = O_YP + (size_t)TP * DM, O_PH = O_YS + NB * DM, O_PC = O_PH + 2 * 256, O_PK = O_PC + 2 * 3 * 256, O_PV = O_PK + 2 * 2048 * 256,
                 O_PP = O_PV + 2 * 2048 * 256, O_PG = O_PP + 2 * 15 * 256, O_SH = O_PG + 2 * 8192, O_SC = O_SH + 2 * NB * 256, O_SK = O_SC + 2 * NB * 3 * 256,
                 O_SV = O_SK + 2 * NB * 256, O_SP = O_SV + 2 * NB * 256, O_SG = O_SP + 2 * NB * 15 * 256, O_END = O_SG + 2 * NB * 8192;
static_assert(O_END == 19801600, "output size");
constexpr size_t MiB = 1u << 20;
constexpr size_t WS_CTL = 0, CTL_ZERO_BYTES = 1 * MiB;
constexpr size_t WS_WIN = 2 * MiB, WS_WOUT = 11 * MiB, WS_WUP = 15 * MiB, WS_WDN = 31 * MiB;
constexpr size_t WS_XB = 47 * MiB, WS_Z = 80 * MiB, WS_Y = 154 * MiB, WS_MIX = 187 * MiB, WS_U = 252 * MiB;
constexpr size_t WS_RSTD = 382 * MiB, WS_DLR = 383 * MiB, WS_HLOC = 385 * MiB, WS_PCUM = 401 * MiB, WS_LAGG = 417 * MiB;
constexpr size_t WS_GDS = 419 * MiB, WS_GDEC = 427 * MiB, WS_GB = 428 * MiB, WS_BIAS = 436 * MiB, WS_PART = 437 * MiB, WS_VT = 438 * MiB, WS_END = 463 * MiB;
constexpr int CW_BAR = 4096;
constexpr int LDS_BYTES = 147456, MISC_OFF = 131072 + 320;

__constant__ unsigned char BUCKET[387] = {
0,1,2,3,4,5,6,7,8,9,10,11,12,13,14,15,16,16,16,16,16,16,17,17,17,17,17,17,17,17,18,18,18,18,18,18,18,18,18,18,19,19,19,19,19,19,19,19,19,19,19,19,19,19,20,20,20,20,20,20,20,20,20,20,20,20,20,20,20,20,20,20,20,21,21,21,21,21,21,21,21,21,21,21,21,21,21,21,21,21,21,21,21,21,21,21,21,21,21,22,22,22,22,22,22,22,22,22,22,22,22,22,22,22,22,22,22,22,22,22,22,22,22,22,22,22,22,22,22,
0,4,8,12,16,16,17,17,18,18,19,19,19,19,20,20,20,20,20,21,21,21,21,21,21,22,22,22,22,22,22,22,22,22,23,23,23,23,23,23,23,23,23,23,23,23,24,24,24,24,24,24,24,24,24,24,24,24,24,24,24,24,25,25,25,25,25,25,25,25,25,25,25,25,25,25,25,25,25,25,25,25,25,26,26,26,26,26,26,26,26,26,26,26,26,26,26,26,26,26,26,26,26,26,26,26,26,26,26,26,26,26,26,27,27,27,27,27,27,27,27,27,27,27,27,27,27,27,27,
0,16,18,19,20,21,21,22,22,23,23,23,24,24,24,24,25,25,25,25,25,26,26,26,26,26,26,26,26,27,27,27,27,27,27,27,27,27,27,28,28,28,28,28,28,28,28,28,28,28,28,28,29,29,29,29,29,29,29,29,29,29,29,29,29,29,29,29,29,29,30,30,30,30,30,30,30,30,30,30,30,30,30,30,30,30,30,30,30,30,30,30,30,30,30,31,31,31,31,31,31,31,31,31,31,31,31,31,31,31,31,31,31,31,31,31,31,31,31,31,31,31,31,31,31,31,31,31,31};

#define XB_TMO      128
#define XB_XCNT(j)  (256  + 64 * (j))
#define XB_XSUB(j)  (1280 + 64 * (j))
#define XB_XGEN(j)  (2304 + 64 * (j))
#define XB_TOP      3328
#define XB_TOPGEN   3392
#define XCD_BAR_WORDS 3456
#define XB_SPIN_CAP (1u << 18)
__device__ __forceinline__ unsigned xb_ld(unsigned* p)              { return __hip_atomic_load(p, __ATOMIC_RELAXED, __HIP_MEMORY_SCOPE_AGENT); }
__device__ __forceinline__ unsigned xb_add(unsigned* p, unsigned v) { return __hip_atomic_fetch_add(p, v, __ATOMIC_RELAXED, __HIP_MEMORY_SCOPE_AGENT); }
__device__ __forceinline__ unsigned xb_xcc_id() { return (unsigned)__builtin_amdgcn_s_getreg((3 << 11) | 20) & 0xFu; }
#define XB_SPIN(cond, bar) do { unsigned _sp = 0; while (cond) { __builtin_amdgcn_s_sleep(1); \
    if ((++_sp & 255u) == 0u) { if (xb_ld(&(bar)[XB_TMO])) break; if (_sp > XB_SPIN_CAP) { atomicAdd(&(bar)[XB_TMO], 1u); break; } } } } while (0)
struct XcdBarrier { unsigned* bar; unsigned x; volatile LAS unsigned* st; };
__device__ __forceinline__ XcdBarrier xcd_barrier_post(unsigned* bar, volatile LAS unsigned* st) {
    XcdBarrier b; b.bar = bar; b.x = xb_xcc_id(); b.st = st;
    if (threadIdx.x == 0) (void)xb_add(&bar[XB_XCNT(b.x)], 1u);
    return b;
}
__device__ __forceinline__ void xcd_barrier_complete(unsigned* bar, unsigned x, unsigned& nloc, unsigned& nx) {
    const unsigned G = gridDim.x * gridDim.y * gridDim.z;
    unsigned sum, cnt, mine, sp = 0u;
    for (;;) {
        sum = 0u; cnt = 0u; mine = 0u;
#pragma unroll
        for (unsigned j = 0; j < 16; ++j) { const unsigned c = xb_ld(&bar[XB_XCNT(j)]); sum += c; cnt += (c > 0u) ? 1u : 0u; mine = (j == x) ? c : mine; }
        if (sum == G) break;
        __builtin_amdgcn_s_sleep(1);
        if ((++sp & 255u) == 0u) { if (xb_ld(&bar[XB_TMO])) break; if (sp > XB_SPIN_CAP) { atomicAdd(&bar[XB_TMO], 1u); break; } }
    }
    nloc = mine > 0u ? mine : 1u; nx = cnt > 0u ? cnt : 1u;
}
__device__ __forceinline__ void xcd_barrier(const XcdBarrier& b) {
    asm volatile("s_waitcnt vmcnt(0)" ::: "memory");
    __syncthreads();
    if (threadIdx.x == 0) {
        unsigned* bar = b.bar;
        __builtin_amdgcn_s_waitcnt(0);
        unsigned nloc = b.st[0], nx = b.st[1];
        if (nloc == 0u) { xcd_barrier_complete(bar, b.x, nloc, nx); b.st[0] = nloc; b.st[1] = nx; }
        const unsigned old = xb_add(&bar[XB_XSUB(b.x)], 1u);
        const unsigned gen = old / nloc;
        if (old + 1u == (gen + 1u) * nloc) {
            __builtin_amdgcn_fence(__ATOMIC_RELEASE, "agent");
            asm volatile("s_waitcnt vmcnt(0)" ::: "memory");
            const unsigned og = xb_add(&bar[XB_TOP], 1u);
            const unsigned tg = og / nx;
            if (og + 1u == (tg + 1u) * nx) xb_add(&bar[XB_TOPGEN], 1u);
            else XB_SPIN(xb_ld(&bar[XB_TOPGEN]) == tg, bar);
            __builtin_amdgcn_fence(__ATOMIC_ACQUIRE, "agent");
            xb_add(&bar[XB_XGEN(b.x)], 1u);
            asm volatile("s_waitcnt vmcnt(0)" ::: "memory");
        } else {
            XB_SPIN(xb_ld(&bar[XB_XGEN(b.x)]) == gen, bar);
            __builtin_amdgcn_fence(__ATOMIC_ACQUIRE, "agent");
            asm volatile("s_waitcnt vmcnt(0)" ::: "memory");
        }
    }
    __syncthreads();
}

#define LDS_WAIT() asm volatile("s_waitcnt lgkmcnt(0)" ::: "memory")
__device__ __forceinline__ float bf2f(bf16_t b) { return __uint_as_float((unsigned)b << 16); }
__device__ __forceinline__ float bflo(unsigned w) { return __uint_as_float(w << 16); }
__device__ __forceinline__ float bfhi(unsigned w) { return __uint_as_float(w & 0xffff0000u); }
__device__ __forceinline__ unsigned f2bf(float f) { unsigned u = __float_as_uint(f); return (u + 0x7fffu + ((u >> 16) & 1u)) >> 16; }
__device__ __forceinline__ unsigned pk2(float lo, float hi) { return f2bf(lo) | (f2bf(hi) << 16); }
__device__ __forceinline__ float wave_sum(float v) {
#pragma unroll
    for (int o = 1; o < 64; o <<= 1) v += __shfl_xor(v, o);
    return v;
}
__device__ __forceinline__ float wave_max(float v) {
#pragma unroll
    for (int o = 1; o < 64; o <<= 1) v = fmaxf(v, __shfl_xor(v, o));
    return v;
}
__device__ __forceinline__ float sigmoidf_(float x) { return 1.0f / (1.0f + __expf(-x)); }
__device__ __forceinline__ float logsigmoidf_(float x) { return fminf(x, 0.f) - log1pf(__expf(-fabsf(x))); }
__device__ __forceinline__ float gelu_tanh(float x) { const float u = 0.7978845608028654f * (x + 0.044715f * x * x * x); return 0.5f * x * (1.0f + tanhf(u)); }
__device__ __forceinline__ float siluf_(float x) { return x / (1.0f + __expf(-x)); }

struct Args { const float* in[N_INPUTS]; float* out; unsigned char* ws; };

__device__ __forceinline__ void p0_transpose_item(const float* W, int ldw, int K, int Ncols, const float* kscale, bf16_t* WT, LAS float* scr, int item, int lane) {
    const int nblk = Ncols / 32, kb = item / nblk, nb = item % nblk, k0 = 64 * kb, n0 = 32 * nb;
#pragma unroll 8
    for (int i = 0; i < 32; ++i) { const int kk = 2 * i + (lane >> 5); const float s = kscale ? kscale[k0 + kk] : 1.0f; scr[kk * 33 + (lane & 31)] = W[(size_t)(k0 + kk) * ldw + n0 + (lane & 31)] * s; }
    LDS_WAIT(); asm volatile("" ::: "memory");
    const int c = lane & 7;
#pragma unroll
    for (int j = 0; j < 4; ++j) { const int n = (lane >> 3) + 8 * j; const LAS float* s = scr + (8 * c) * 33 + n;
        u32x4 o; o.x = pk2(s[0 * 33], s[1 * 33]); o.y = pk2(s[2 * 33], s[3 * 33]); o.z = pk2(s[4 * 33], s[5 * 33]); o.w = pk2(s[6 * 33], s[7 * 33]);
        *(u32x4*)(WT + (size_t)(n0 + n) * K + k0 + 8 * c) = o; }
    LDS_WAIT(); asm volatile("" ::: "memory");
}

template <bool HAS_MIX, bool WANT_DLR>
__device__ __forceinline__ void rowpass(LAS unsigned char* lds, const float* xsrcP, const float* xsrcS, float* xdst, const float* mix, const float* gpost,
                                        const float* gpre_next, const float* win_next, bf16_t* XB, float* RSTD, float* DLR, int gw, int NGW, int tid) {
    const int lane = tid & 63;
    LAS float* WLT = (LAS float*)lds;
    if (WANT_DLR) {
        for (int idx = tid; idx < 16384; idx += NT) { const int k = idx >> 4, j = idx & 15; WLT[j * 1028 + k] = gpre_next[k] * win_next[(size_t)k * NIN + NZ + j]; }
        __syncthreads();
    }
    for (int row = gw; row < NROWS; row += NGW) {
        const float* xs = (row < TP) ? xsrcP + (size_t)row * DM : xsrcS + (size_t)(row - TP) * DM;
        f32x4 v[4];
#pragma unroll
        for (int j = 0; j < 4; ++j) v[j] = *(const f32x4*)(xs + 4 * lane + 256 * j);
        if (HAS_MIX) {
            f32x4 mv[4]; float s = 0.f;
#pragma unroll
            for (int j = 0; j < 4; ++j) { mv[j] = *(const f32x4*)(mix + (size_t)row * DM + 4 * lane + 256 * j); s += (mv[j].x * mv[j].x + mv[j].y * mv[j].y) + (mv[j].z * mv[j].z + mv[j].w * mv[j].w); }
            const float rm = rsqrtf(wave_sum(s) * (1.0f / DM) + EPS);
#pragma unroll
            for (int j = 0; j < 4; ++j) { const f32x4 g = *(const f32x4*)(gpost + 4 * lane + 256 * j); v[j] = v[j] + mv[j] * rm * g; }
        }
        if (xdst) {
#pragma unroll
            for (int j = 0; j < 4; ++j) *(f32x4*)(xdst + (size_t)row * DM + 4 * lane + 256 * j) = v[j];
        }
        float s2 = 0.f;
#pragma unroll
        for (int j = 0; j < 4; ++j) s2 += (v[j].x * v[j].x + v[j].y * v[j].y) + (v[j].z * v[j].z + v[j].w * v[j].w);
        const float rstd = rsqrtf(wave_sum(s2) * (1.0f / DM) + EPS);
        if (lane == 0) RSTD[row] = rstd;
#pragma unroll
        for (int j = 0; j < 4; ++j) { u32x2 w; w.x = pk2(v[j].x, v[j].y); w.y = pk2(v[j].z, v[j].w); *(u32x2*)(XB + (size_t)row * DM + 4 * lane + 256 * j) = w; }
        if (WANT_DLR) {
            float mine = 0.f; int lo = 4 * lane; asm volatile("" : "+v"(lo));
#pragma unroll
            for (int jj = 0; jj < 16; ++jj) {
                float a = 0.f;
#pragma unroll
                for (int j = 0; j < 4; ++j) { const f32x4 w = *(const LAS f32x4*)(WLT + jj * 1028 + lo + 256 * j); a += (v[j].x * w.x + v[j].y * w.y) + (v[j].z * w.z + v[j].w * w.w); }
                a = wave_sum(a);
                if ((lo >> 2) == jj) mine = a;
            }
            if (lane < 16) DLR[(size_t)row * 16 + lane] = mine * rstd;
        }
    }
    if (WANT_DLR) __syncthreads();
}

struct LayerP {
    const float *conv_w, *conv_b, *wa, *ba, *wx, *bx, *lam, *pool_w, *pool_s, *w_lr, *gla_b, *gla_n;
    const float *slh, *slc, *ck, *cv, *spool, *sgla;
    int l;
};
struct WsP { bf16_t *XB, *Z, *Y, *U; float *MIX, *RSTD, *DLR, *HLOC, *PCUM, *LA, *LH, *HIN, *GDS, *GDEC, *GB, *BIAS; };

constexpr int XS = 68;

__device__ __forceinline__ void lru_local(LAS unsigned char* lds, int tile, const LayerP& L, const WsP& W, float* out, int tid) {
    asm volatile("" : "+v"(tid));
    LAS float* XT = (LAS float*)lds;
    const int ch = tid & 255, half = tid >> 8, h = ch >> 6, j = ch & 63;
    const int t0 = tile * 64 + half * 32;
    const bf16_t* zc = W.Z + C_AU + ch;
    const float w0 = L.conv_w[ch], w1 = L.conv_w[256 + ch], w2 = L.conv_w[512 + ch], w3 = L.conv_w[768 + ch], cb = L.conv_b[ch];
    float am3 = (t0 >= 3) ? bf2f(zc[(size_t)(t0 - 3) * NZ]) : 0.f, am2 = (t0 >= 3) ? bf2f(zc[(size_t)(t0 - 2) * NZ]) : 0.f, am1 = (t0 >= 3) ? bf2f(zc[(size_t)(t0 - 1) * NZ]) : 0.f;
    float u[32];
#pragma unroll
    for (int tok = 0; tok < 32; ++tok) { const float a0 = bf2f(zc[(size_t)(t0 + tok) * NZ]); u[tok] = cb + w0 * am3 + w1 * am2 + w2 * am1 + w3 * a0; am3 = am2; am2 = am1; am1 = a0;
        XT[ch * XS + half * 32 + tok] = u[tok]; }
    if (tile == 255 && half == 1) { float* o = out + O_PC + (size_t)L.l * 768 + ch; o[0] = am3; o[256] = am2; o[512] = am1; }
    __syncthreads();
    float r[32], gi[32];
#pragma unroll
    for (int tok = 0; tok < 32; ++tok) { r[tok] = 0.f; gi[tok] = 0.f; }
    const float* wa = L.wa + h * 4096 + j; const float* wx = L.wx + h * 4096 + j;
    for (int i = 0; i < 64; ++i) {
        const float a_ = wa[i * 64], x_ = wx[i * 64];
        const LAS f32x4* xr = (const LAS f32x4*)(XT + (h * 64 + i) * XS + half * 32);
#pragma unroll
        for (int q = 0; q < 8; ++q) { const f32x4 xv = xr[q];
#pragma unroll
            for (int e = 0; e < 4; ++e) { r[4 * q + e] += xv[e] * a_; gi[4 * q + e] += xv[e] * x_; } }
    }
    const float ba = L.ba[ch], bx = L.bx[ch], c8 = -8.0f * log1pf(__expf(-L.lam[ch]));
    float P = 1.f, hl = 0.f;
#pragma unroll
    for (int tok = 0; tok < 32; ++tok) {
        const float rr = sigmoidf_(r[tok] + ba), gg = sigmoidf_(gi[tok] + bx), la = c8 * rr, a = __expf(la);
        const float inp = sqrtf(-expm1f(2.0f * la)) * (gg * u[tok]);
        hl = a * hl + inp; P *= a;
        W.HLOC[(size_t)(t0 + tok) * 256 + ch] = hl; W.PCUM[(size_t)(t0 + tok) * 256 + ch] = P;
    }
    const int seg = tile * 2 + half;
    W.LA[seg * 256 + ch] = P; W.LH[seg * 256 + ch] = hl;
    __syncthreads();
}

__device__ __forceinline__ void gla_local(LAS unsigned char* lds, int c, const LayerP& L, const WsP& W, int tid) {
    asm volatile("" : "+v"(tid));
    LAS float* Bc = (LAS float*)lds;
    LAS float* Kd = Bc + 8192;
    LAS float* Vs = Kd + 8192;
    const int t0 = c * 64;
    {
        const int n = tid & 127, q = tid >> 7;
        float wl[16];
#pragma unroll
        for (int jj = 0; jj < 16; ++jj) wl[jj] = L.w_lr[jj * 128 + n];
        const float gb = L.gla_b[n];
        for (int tt = 0; tt < 16; ++tt) { const int tok = q * 16 + tt; const float* d = W.DLR + (size_t)(t0 + tok) * 16; float a = gb;
#pragma unroll
            for (int jj = 0; jj < 16; ++jj) a += d[jj] * wl[jj];
            Bc[tok * 128 + n] = logsigmoidf_(a) * (1.0f / 16.0f); }
    }
    __syncthreads();
    if (tid < 128) { float s = 0.f; for (int tok = 0; tok < 64; ++tok) { s += Bc[tok * 128 + tid]; Bc[tok * 128 + tid] = s; W.GB[(size_t)(t0 + tok) * 128 + tid] = s; } }
    for (int idx = tid; idx < 64 * 16; idx += NT) { const int tok = idx >> 4, c8 = idx & 15; const u32x4 v = *(const u32x4*)(W.Z + (size_t)(t0 + tok) * NZ + C_DK + c8 * 8); LAS float* o = Kd + tok * 128 + c8 * 8;
        o[0] = bflo(v.x); o[1] = bfhi(v.x); o[2] = bflo(v.y); o[3] = bfhi(v.y); o[4] = bflo(v.z); o[5] = bfhi(v.z); o[6] = bflo(v.w); o[7] = bfhi(v.w); }
    for (int idx = tid; idx < 64 * 32; idx += NT) { const int tok = idx >> 5, c8 = idx & 31; const u32x4 v = *(const u32x4*)(W.Z + (size_t)(t0 + tok) * NZ + C_DV + c8 * 8); LAS float* o = Vs + tok * 256 + c8 * 8;
        o[0] = bflo(v.x); o[1] = bfhi(v.x); o[2] = bflo(v.y); o[3] = bfhi(v.y); o[4] = bflo(v.z); o[5] = bfhi(v.z); o[6] = bflo(v.w); o[7] = bfhi(v.w); }
    __syncthreads();
    for (int idx = tid; idx < 8192; idx += NT) { const int n = idx & 127; Kd[idx] *= __expf(Bc[63 * 128 + n] - Bc[idx]); }
    __syncthreads();
    {
        const int h = tid >> 7, dk = (tid & 127) >> 2, dv0 = (tid & 3) * 16;
        float acc[16];
#pragma unroll
        for (int e = 0; e < 16; ++e) acc[e] = 0.f;
        for (int jt = 0; jt < 64; ++jt) { const float kd = Kd[jt * 128 + h * 32 + dk]; const LAS f32x4* vp = (const LAS f32x4*)(Vs + jt * 256 + h * 64 + dv0);
#pragma unroll
            for (int q = 0; q < 4; ++q) { const f32x4 vv = vp[q];
#pragma unroll
                for (int e = 0; e < 4; ++e) acc[4 * q + e] += kd * vv[e]; } }
        float* o = W.GDS + ((size_t)(c * 4 + h) * 32 + dk) * 64 + dv0;
#pragma unroll
        for (int q = 0; q < 4; ++q) *(f32x4*)(o + 4 * q) = (f32x4){acc[4 * q], acc[4 * q + 1], acc[4 * q + 2], acc[4 * q + 3]};
        if ((tid & 3) == 0) W.GDEC[c * 128 + h * 32 + dk] = __expf(Bc[63 * 128 + h * 32 + dk]);
    }
    __syncthreads();
}

__device__ __forceinline__ void pool_tile(LAS unsigned char* lds, int tile, const LayerP& L, const WsP& W, float* out, int tid) {
    asm volatile("" : "+v"(tid));
    LAS float* PT = (LAS float*)lds;
    LAS bf16_t* CU = (LAS bf16_t*)(lds + 256 * XS * 4);
    const int t0 = tile * 64;
    for (int idx = tid; idx < 79 * 32; idx += NT) { const int r = idx >> 5, c8 = idx & 31; const int t = t0 - 15 + r;
        u32x4 v = (u32x4){0u, 0u, 0u, 0u}; if (t >= 0) v = *(const u32x4*)(W.Z + (size_t)t * NZ + C_CU + c8 * 8);
        *(LAS u32x4*)(CU + r * 256 + c8 * 8) = v; }
    __syncthreads();
    const int ch = tid & 255, half = tid >> 8, g = ch >> 6, w = 2 << g;
    if (tile == 255) { for (int r = 64 + half; r < 79; r += 2) out[O_PP + (size_t)L.l * 3840 + (r - 64) * 256 + ch] = bf2f(CU[r * 256 + ch]); }
    for (int tok = 0; tok < 32; ++tok) { const int tl = half * 32 + tok, t = t0 + tl; float s = 0.f;
        for (int i = 0; i < w; ++i) s += bf2f(CU[(15 + tl - i) * 256 + ch]);
        const float cnt = (float)((t + 1 < w) ? (t + 1) : w);
        PT[ch * XS + tl] = s / cnt - bf2f(CU[(15 + tl) * 256 + ch]); }
    __syncthreads();
    float acc[32];
#pragma unroll
    for (int tok = 0; tok < 32; ++tok) acc[tok] = 0.f;
    const float* wp = L.pool_w + g * 4096 + (ch & 63);
    for (int i = 0; i < 64; ++i) { const float w_ = wp[i * 64]; const LAS f32x4* xr = (const LAS f32x4*)(PT + (g * 64 + i) * XS + half * 32);
#pragma unroll
        for (int q = 0; q < 8; ++q) { const f32x4 xv = xr[q];
#pragma unroll
            for (int e = 0; e < 4; ++e) acc[4 * q + e] += xv[e] * w_; } }
    const float sc = L.pool_s[ch];
#pragma unroll
    for (int tok = 0; tok < 32; ++tok) W.Y[(size_t)(t0 + half * 32 + tok) * DM + 512 + ch] = (bf16_t)f2bf(acc[tok] * sc);
    __syncthreads();
}

__device__ __forceinline__ void unpack8(const u32x4 v, float* d) { d[0] = bflo(v.x); d[1] = bfhi(v.x); d[2] = bflo(v.y); d[3] = bfhi(v.y); d[4] = bflo(v.z); d[5] = bfhi(v.z); d[6] = bflo(v.w); d[7] = bfhi(v.w); }

typedef short bf16x8s __attribute__((ext_vector_type(8)));
constexpr int VT_LDS_STRIDE = 258;
__device__ __forceinline__ void vt_repack(LAS unsigned char* lds, int tile, const WsP& W, bf16_t* VT, int tid) {
    asm volatile("" : "+v"(tid));
    LAS bf16_t* VL = (LAS bf16_t*)lds;
    const int t0 = tile * 64;
    for (int idx = tid; idx < 64 * 128; idx += NT) { const int tok = idx >> 7, c2 = idx & 127;
        *(LAS unsigned*)(VL + tok * VT_LDS_STRIDE + 2 * c2) = *(const unsigned*)(W.Z + (size_t)(t0 + tok) * NZ + C_BV + 2 * c2); }
    __syncthreads();
#pragma unroll 4
    for (int k = 0; k < 24; ++k) {
        const int idx = tid + NT * k, p = idx >> 12, rem = idx & 4095, c = rem & 255, gq = rem >> 8;
        const int d = 1 << (2 * p);
        const int tb = (p == 0) ? 4 * gq : ((p == 1) ? (gq & 3) + 16 * (gq >> 2) : gq);
        const int di = (p == 0) ? t0 + 4 * gq : ((p == 1) ? (gq & 3) * (TP / 4) + t0 / 4 + 4 * (gq >> 2) : gq * (TP / 16) + t0 / 16);
        const unsigned e0 = VL[(tb) * VT_LDS_STRIDE + c], e1 = VL[(tb + d) * VT_LDS_STRIDE + c], e2 = VL[(tb + 2 * d) * VT_LDS_STRIDE + c], e3 = VL[(tb + 3 * d) * VT_LDS_STRIDE + c];
        u32x2 w; w.x = e0 | (e1 << 16); w.y = e2 | (e3 << 16);
        *(u32x2*)(VT + ((size_t)(p * 256 + c)) * TP + di) = w;
    }
    __syncthreads();
}
struct AttnFrag { bf16x8s k[2][2]; u32x2 v[4][2]; };
template <int P>
__device__ __forceinline__ AttnFrag attn_load(const bf16_t* Zk, const bf16_t* VTp, int ub0, int r, int pr, int q, int g) {
    constexpr int d = 1 << (2 * P);
    AttnFrag f;
#pragma unroll
    for (int tl = 0; tl < 2; ++tl) {
        const int kb = 2 * pr + tl;
        int pos = r + d * (ub0 + 16 * kb + q); pos = pos < 0 ? 0 : (pos > TP - 1 ? TP - 1 : pos);
        const bf16_t* kp = Zk + (size_t)pos * NZ;
        f.k[tl][0] = *(const bf16x8s*)(kp); f.k[tl][1] = *(const bf16x8s*)(kp + 32);
        int u4 = ub0 + 16 * kb + 4 * g; u4 = u4 < 0 ? 0 : (u4 > TP / d - 4 ? TP / d - 4 : u4);
        const bf16_t* vp = VTp + r * (TP / d) + u4;
#pragma unroll
        for (int nb = 0; nb < 4; ++nb) f.v[nb][tl] = *(const u32x2*)(vp + (size_t)nb * 16 * TP);
    }
    return f;
}
template <int P>
__device__ __forceinline__ void attn_compute(const AttnFrag& f, const bf16x8s (&qf)[2], const LAS float* BLp, int jb, int jmax, int pr, f32x4 (&oacc)[4], float& m, float& l) {
    f32x4 sA = (f32x4){0.f, 0.f, 0.f, 0.f}, sB = (f32x4){0.f, 0.f, 0.f, 0.f};
    sA = __builtin_amdgcn_mfma_f32_16x16x32_bf16(f.k[0][0], qf[0], sA, 0, 0, 0); sA = __builtin_amdgcn_mfma_f32_16x16x32_bf16(f.k[0][1], qf[1], sA, 0, 0, 0);
    sB = __builtin_amdgcn_mfma_f32_16x16x32_bf16(f.k[1][0], qf[0], sB, 0, 0, 0); sB = __builtin_amdgcn_mfma_f32_16x16x32_bf16(f.k[1][1], qf[1], sB, 0, 0, 0);
    const int jA0 = jb - 32 * pr;
    bool vA[4], vB[4]; float mx = -1.0e30f;
#pragma unroll
    for (int e = 0; e < 4; ++e) {
        const int jA = jA0 - e, jB = jA0 - 16 - e;
        vA[e] = (unsigned)jA <= (unsigned)jmax; vB[e] = (unsigned)jB <= (unsigned)jmax;
        sA[e] = vA[e] ? sA[e] * 0.125f + BLp[jA] : -1.0e30f; sB[e] = vB[e] ? sB[e] * 0.125f + BLp[jB] : -1.0e30f;
        mx = fmaxf(mx, fmaxf(sA[e], sB[e]));
    }
    mx = fmaxf(mx, __shfl_xor(mx, 16)); mx = fmaxf(mx, __shfl_xor(mx, 32));
    const float mn = fmaxf(m, mx), alpha = __expf(m - mn);
    m = mn;
    float pA[4], pB[4], rs = 0.f;
#pragma unroll
    for (int e = 0; e < 4; ++e) { pA[e] = vA[e] ? __expf(sA[e] - mn) : 0.f; pB[e] = vB[e] ? __expf(sB[e] - mn) : 0.f; rs += pA[e] + pB[e]; }
    l = l * alpha + rs;
    union { bf16x8s v; unsigned u[4]; } pf;
    pf.u[0] = pk2(pA[0], pA[1]); pf.u[1] = pk2(pA[2], pA[3]); pf.u[2] = pk2(pB[0], pB[1]); pf.u[3] = pk2(pB[2], pB[3]);
#pragma unroll
    for (int nb = 0; nb < 4; ++nb) {
        union { bf16x8s v; unsigned u[4]; } vf; vf.u[0] = f.v[nb][0].x; vf.u[1] = f.v[nb][0].y; vf.u[2] = f.v[nb][1].x; vf.u[3] = f.v[nb][1].y;
        oacc[nb] = oacc[nb] * alpha;
        oacc[nb] = __builtin_amdgcn_mfma_f32_16x16x32_bf16(vf.v, pf.v, oacc[nb], 0, 0, 0);
    }
}
template <int P>
__device__ __forceinline__ void attn_pattern(const WsP& W, const bf16_t* VT, const LAS float* BL, int h, int t0, int rho, int q, int g, const bf16x8s (&qf)[2], f32x4 (&oacc)[4], float& m, float& l) {
    constexpr int d = 1 << (2 * P), a = 16 >> (2 * P), NP = (P == 0) ? 12 : ((P == 1) ? 6 : 5);
    const int r = rho & (d - 1), uq0 = (t0 + rho) >> (2 * P), ub0 = (uq0 - 128) & ~15, off = uq0 - 128 - ub0;
    const int uqi = uq0 + a * q, jmax = uqi < 128 ? uqi : 128, jb = a * q + off + 128 - 4 * g;
    const bf16_t* Zk = W.Z + C_BK + h * 64 + 8 * g;
    const bf16_t* VTp = VT + ((size_t)(P * 256 + h * 64 + q)) * TP;
    const LAS float* BLp = BL + P * 640 + 256;
    AttnFrag cur = attn_load<P>(Zk, VTp, ub0, r, 0, q, g);
#pragma unroll 1
    for (int pr = 0; pr < NP; ++pr) {
        const AttnFrag nxt = attn_load<P>(Zk, VTp, ub0, r, (pr + 1 < NP) ? pr + 1 : pr, q, g);
        attn_compute<P>(cur, qf, BLp, jb, jmax, pr, oacc, m, l);
        cur = nxt;
    }
}
__device__ __forceinline__ void attn_mfma_item(const LAS float* BL, const WsP& W, const bf16_t* VT, int h, int tb, int rho, int lane) {
    asm volatile("" : "+v"(lane));
    const int q = lane & 15, g = lane >> 4, t0 = tb * 256, tq = t0 + rho + 16 * q;
    bf16x8s qf[2];
    { const bf16_t* qp = W.Z + (size_t)tq * NZ + C_BQ + h * 64 + 8 * g; qf[0] = *(const bf16x8s*)qp; qf[1] = *(const bf16x8s*)(qp + 32); }
    f32x4 oacc[4];
#pragma unroll
    for (int nb = 0; nb < 4; ++nb) oacc[nb] = (f32x4){0.f, 0.f, 0.f, 0.f};
    float m = -1.0e30f, l = 0.f;
    attn_pattern<0>(W, VT, BL, h, t0, rho, q, g, qf, oacc, m, l);
    attn_pattern<1>(W, VT, BL, h, t0, rho, q, g, qf, oacc, m, l);
    attn_pattern<2>(W, VT, BL, h, t0, rho, q, g, qf, oacc, m, l);
    l += __shfl_xor(l, 16); l += __shfl_xor(l, 32);
    const float inv = 1.0f / l;
    bf16_t* yp = W.Y + (size_t)tq * DM + 256 + h * 64 + 4 * g;
#pragma unroll
    for (int nb = 0; nb < 4; ++nb) { u32x2 w; w.x = pk2(oacc[nb][0] * inv, oacc[nb][1] * inv); w.y = pk2(oacc[nb][2] * inv, oacc[nb][3] * inv); *(u32x2*)(yp + 16 * nb) = w; }
}
__device__ __forceinline__ void attn_sample_part(const LayerP& L, const WsP& W, float* PART, int si, int lane) {
    asm volatile("" : "+v"(lane));
    const int chunk = si & 7, bh = si >> 3, b = bh >> 2, h = bh & 3, sg = lane >> 4, dg = lane & 15;
    const size_t zrow = (size_t)(TP + b) * NZ;
    float q[4];
    { const u32x2 w = *(const u32x2*)(W.Z + zrow + C_BQ + h * 64 + dg * 4); q[0] = bflo(w.x); q[1] = bfhi(w.x); q[2] = bflo(w.y); q[3] = bfhi(w.y); }
    const float* ckb = L.ck + (size_t)b * 2048 * 256 + h * 64 + dg * 4; const float* cvb = L.cv + (size_t)b * 2048 * 256 + h * 64 + dg * 4;
    float lg[13]; float m = -3.0e38f;
#pragma unroll
    for (int i = 0; i < 13; ++i) {
        const int sl = i * 4 + sg, s = chunk * 49 + sl; const bool valid = (sl < 49) && (s < 387);
        const int p = (s >= 258) ? 2 : ((s >= 129) ? 1 : 0); const int jj = s - 129 * p; const int idx = 2048 - (jj << (2 * p));
        float d = 0.f;
        if (valid) {
            f32x4 kk;
            if (idx == 2048) { const u32x2 w = *(const u32x2*)(W.Z + zrow + C_BK + h * 64 + dg * 4); kk = (f32x4){bflo(w.x), bfhi(w.x), bflo(w.y), bfhi(w.y)}; }
            else kk = *(const f32x4*)(ckb + (size_t)idx * 256);
            d = (q[0] * kk.x + q[1] * kk.y) + (q[2] * kk.z + q[3] * kk.w);
        }
        d += __shfl_xor(d, 1); d += __shfl_xor(d, 2); d += __shfl_xor(d, 4); d += __shfl_xor(d, 8);
        lg[i] = valid ? d * 0.125f + W.BIAS[h * 388 + (valid ? s : 0)] : -1.0e30f;
        m = fmaxf(m, lg[i]);
    }
    m = fmaxf(m, __shfl_xor(m, 16)); m = fmaxf(m, __shfl_xor(m, 32));
    float o[4] = {0.f, 0.f, 0.f, 0.f}; float sum = 0.f;
#pragma unroll
    for (int i = 0; i < 13; ++i) {
        const int sl = i * 4 + sg, s = chunk * 49 + sl; const bool valid = (sl < 49) && (s < 387);
        const int p = (s >= 258) ? 2 : ((s >= 129) ? 1 : 0); const int jj = s - 129 * p; const int idx = 2048 - (jj << (2 * p));
        if (valid) {
            const float pr = __expf(lg[i] - m); sum += pr;
            f32x4 vv;
            if (idx == 2048) { const u32x2 w = *(const u32x2*)(W.Z + zrow + C_BV + h * 64 + dg * 4); vv = (f32x4){bflo(w.x), bfhi(w.x), bflo(w.y), bfhi(w.y)}; }
            else vv = *(const f32x4*)(cvb + (size_t)idx * 256);
            o[0] += pr * vv.x; o[1] += pr * vv.y; o[2] += pr * vv.z; o[3] += pr * vv.w;
        }
    }
    sum += __shfl_xor(sum, 16); sum += __shfl_xor(sum, 32);
#pragma unroll
    for (int e = 0; e < 4; ++e) { o[e] += __shfl_xor(o[e], 16); o[e] += __shfl_xor(o[e], 32); }
    float* pp = PART + (size_t)si * 72;
    if (sg == 0) *(f32x4*)(pp + dg * 4) = (f32x4){o[0], o[1], o[2], o[3]};
    if (lane == 0) { pp[64] = m; pp[65] = sum; }
}
__device__ __forceinline__ void attn_sample_combine(const WsP& W, const float* PART, int bh, int lane) {
    asm volatile("" : "+v"(lane));
    const float* pp = PART + (size_t)bh * 8 * 72;
    float mc[8], M = -3.0e38f;
#pragma unroll
    for (int c = 0; c < 8; ++c) { mc[c] = pp[c * 72 + 64]; M = fmaxf(M, mc[c]); }
    float S = 0.f, o = 0.f;
#pragma unroll
    for (int c = 0; c < 8; ++c) { const float f = __expf(mc[c] - M); S += pp[c * 72 + 65] * f; o += pp[c * 72 + lane] * f; }
    const int b = bh >> 2, h = bh & 3;
    W.Y[(size_t)(TP + b) * DM + 256 + h * 64 + lane] = (bf16_t)f2bf(o / S);
}

__device__ __forceinline__ void sample_mixers(LAS unsigned char* lds, int b, const LayerP& L, const WsP& W, float* out, int tid) {
    asm volatile("" : "+v"(tid));
    LAS float* US = (LAS float*)lds;
    LAS float* PS = US + 256;
    LAS float* EG = PS + 256;
    LAS float* QS = EG + 128;
    LAS float* KS = QS + 128;
    LAS float* VV = KS + 128;
    LAS float* OP = VV + 256;
    const int row = TP + b, lb = b;
    const bf16_t* zr = W.Z + (size_t)row * NZ;
    const int l = L.l;
    if (tid < 256) {
        const int ch = tid;
        const float h0 = L.slc[((size_t)lb * 3 + 0) * 256 + ch], h1 = L.slc[((size_t)lb * 3 + 1) * 256 + ch], h2 = L.slc[((size_t)lb * 3 + 2) * 256 + ch], a0 = bf2f(zr[C_AU + ch]);
        US[ch] = L.conv_b[ch] + L.conv_w[ch] * h0 + L.conv_w[256 + ch] * h1 + L.conv_w[512 + ch] * h2 + L.conv_w[768 + ch] * a0;
        float* o = out + O_SC + ((size_t)(l * NB + b) * 3) * 256 + ch; o[0] = h1; o[256] = h2; o[512] = a0;
        out[O_SK + (size_t)(l * NB + b) * 256 + ch] = bf2f(zr[C_BK + ch]);
        out[O_SV + (size_t)(l * NB + b) * 256 + ch] = bf2f(zr[C_BV + ch]);
    } else {
        const int ch = tid - 256, g = ch >> 6, w = 2 << g;
        const float* hp = L.spool + (size_t)lb * 15 * 256 + ch; const float cu = bf2f(zr[C_CU + ch]);
        float s = cu;
#pragma unroll 1
        for (int i = 1; i < w; ++i) s += hp[(15 - i) * 256];
        PS[ch] = s / (float)w - cu;
        float* o = out + O_SP + (size_t)(l * NB + b) * 15 * 256 + ch;
#pragma unroll 2
        for (int r = 0; r < 14; ++r) o[r * 256] = hp[(r + 1) * 256];
        o[14 * 256] = cu;
    }
    if (tid < 128) {
        const int n = tid; float a = L.gla_b[n]; const float* d = W.DLR + (size_t)row * 16;
#pragma unroll
        for (int jj = 0; jj < 16; ++jj) a += d[jj] * L.w_lr[jj * 128 + n];
        EG[n] = __expf(logsigmoidf_(a) * (1.0f / 16.0f)); QS[n] = bf2f(zr[C_DQ + n]) * 0.17677669529663687f; KS[n] = bf2f(zr[C_DK + n]);
    } else if (tid < 384) { VV[tid - 128] = bf2f(zr[C_DV + tid - 128]); }
    __syncthreads();
    if (tid < 256) {
        const int ch = tid, h = ch >> 6, j = ch & 63; float r = 0.f, gi = 0.f;
#pragma unroll 16
        for (int i = 0; i < 64; ++i) { const float uu = US[h * 64 + i]; r += uu * L.wa[h * 4096 + i * 64 + j]; gi += uu * L.wx[h * 4096 + i * 64 + j]; }
        const float rr = sigmoidf_(r + L.ba[ch]), gg = sigmoidf_(gi + L.bx[ch]), la = -8.0f * log1pf(__expf(-L.lam[ch])) * rr, a = __expf(la);
        const float hn = a * L.slh[(size_t)lb * 256 + ch] + sqrtf(-expm1f(2.0f * la)) * (gg * US[ch]);
        out[O_SH + (size_t)(l * NB + b) * 256 + ch] = hn;
        W.Y[(size_t)row * DM + ch] = (bf16_t)f2bf(hn * gelu_tanh(bf2f(zr[C_AG + ch])));
    } else {
        const int d = tid - 256, g = d >> 6; float a = 0.f;
#pragma unroll 16
        for (int c = 0; c < 64; ++c) a += PS[g * 64 + c] * L.pool_w[g * 4096 + c * 64 + (d & 63)];
        W.Y[(size_t)row * DM + 512 + d] = (bf16_t)f2bf(a * L.pool_s[d]);
    }
    {
        const int dv = tid & 63, wv = tid >> 6;
        float po[4] = {0.f, 0.f, 0.f, 0.f};
#pragma unroll
        for (int k = 0; k < 16; ++k) { const int idx = tid + NT * k, hh = idx >> 11, dk = (idx >> 6) & 31;
            const float s0 = L.sgla[(size_t)lb * 8192 + idx]; const float sn = EG[hh * 32 + dk] * s0 + KS[hh * 32 + dk] * VV[hh * 64 + dv];
            out[O_SG + (size_t)(l * NB + b) * 8192 + idx] = sn; po[k >> 2] += QS[hh * 32 + dk] * sn; }
#pragma unroll
        for (int hh = 0; hh < 4; ++hh) OP[wv * 256 + hh * 64 + dv] = po[hh];
    }
    __syncthreads();
    if (tid < 256) {
        float o = 0.f;
#pragma unroll
        for (int wv = 0; wv < 8; ++wv) o += OP[wv * 256 + tid];
        const float ss = wave_sum(o * o);
        const float y = o * rsqrtf(ss * (1.0f / 64.0f) + EPS) * L.gla_n[tid] * siluf_(bf2f(zr[C_DR + tid]));
        W.Y[(size_t)row * DM + 768 + tid] = (bf16_t)f2bf(y);
    }
    __syncthreads();
}

__device__ __forceinline__ void gla_scan_item(LAS unsigned char* lds, int it, const LayerP& L, const WsP& W, float* out, int tid) {
    asm volatile("" : "+v"(tid));
    LAS float* SA = (LAS float*)lds; LAS float* SS = SA + 16;
    const int h = it >> 6, dk = (it >> 1) & 31, dv0 = (it & 1) * 32, cgp = tid >> 5, e = tid & 31;
    float d[16], s[16];
#pragma unroll
    for (int i = 0; i < 16; ++i) { const int c = cgp * 16 + i; d[i] = W.GDEC[c * 128 + h * 32 + dk]; s[i] = W.GDS[((size_t)(c * 4 + h) * 32 + dk) * 64 + dv0 + e]; }
    float A = 1.f, S = 0.f;
#pragma unroll
    for (int i = 0; i < 16; ++i) { S = d[i] * S + s[i]; A *= d[i]; }
    if (e == 0) SA[cgp] = A;
    SS[cgp * 32 + e] = S;
    __syncthreads();
    float Sin = 0.f;
    for (int jg = 0; jg < cgp; ++jg) Sin = SA[jg] * Sin + SS[jg * 32 + e];
    S = Sin;
#pragma unroll
    for (int i = 0; i < 16; ++i) { const int c = cgp * 16 + i; W.GDS[((size_t)(c * 4 + h) * 32 + dk) * 64 + dv0 + e] = S; S = d[i] * S + s[i]; }
    if (cgp == 15) out[O_PG + (size_t)L.l * 8192 + (h * 32 + dk) * 64 + dv0 + e] = S;
    __syncthreads();
}
__device__ __forceinline__ void lru_scan_item(LAS unsigned char* lds, int it, const LayerP& L, const WsP& W, float* out, int tid) {
    asm volatile("" : "+v"(tid));
    LAS float* LA_ = (LAS float*)lds; LAS float* LH_ = LA_ + 512;
    const int e = tid & 15, sg = tid >> 4, ch = it * 16 + e;
    float a[16], hh[16];
#pragma unroll
    for (int i = 0; i < 16; ++i) { const int seg = sg * 16 + i; a[i] = W.LA[seg * 256 + ch]; hh[i] = W.LH[seg * 256 + ch]; }
    float A = 1.f, H = 0.f;
#pragma unroll
    for (int i = 0; i < 16; ++i) { H = a[i] * H + hh[i]; A *= a[i]; }
    LA_[sg * 16 + e] = A; LH_[sg * 16 + e] = H;
    __syncthreads();
    float Hin = 0.f;
    for (int jg = 0; jg < sg; ++jg) Hin = LA_[jg * 16 + e] * Hin + LH_[jg * 16 + e];
    H = Hin;
#pragma unroll
    for (int i = 0; i < 16; ++i) { const int seg = sg * 16 + i; W.HIN[seg * 256 + ch] = H; H = a[i] * H + hh[i]; }
    if (sg == 31) out[O_PH + (size_t)L.l * 256 + ch] = H;
    __syncthreads();
}

__device__ __forceinline__ void lru_final(int tile, const LayerP& L, const WsP& W, int tid) {
    asm volatile("" : "+v"(tid));
    const int ch = tid & 255, half = tid >> 8, seg = tile * 2 + half, t0 = tile * 64 + half * 32;
    const float hin = W.HIN[seg * 256 + ch];
#pragma unroll 4
    for (int tok = 0; tok < 32; ++tok) { const size_t t = (size_t)(t0 + tok);
        const float hv = W.HLOC[t * 256 + ch] + W.PCUM[t * 256 + ch] * hin;
        W.Y[t * DM + ch] = (bf16_t)f2bf(hv * gelu_tanh(bf2f(W.Z[t * NZ + C_AG + ch]))); }
}
__device__ __forceinline__ void gla_final(LAS unsigned char* lds, int c, const LayerP& L, const WsP& W, int tid) {
    asm volatile("" : "+v"(tid));
    LAS float* QB = (LAS float*)lds;
    LAS float* KB = QB + 64 * 33;
    LAS float* VS = KB + 64 * 33;
    LAS float* SS = VS + 4096;
    LAS float* ATT = SS + 2048;
    const int t0 = c * 64, lane = tid & 63, wv = tid >> 6;
    for (int h = 0; h < 4; ++h) {
        for (int idx = tid; idx < 2048; idx += NT) { const int tok = idx >> 5, d = idx & 31; const size_t t = (size_t)(t0 + tok);
            const float bb = W.GB[t * 128 + h * 32 + d];
            QB[tok * 33 + d] = bf2f(W.Z[t * NZ + C_DQ + h * 32 + d]) * 0.17677669529663687f * __expf(bb);
            KB[tok * 33 + d] = bf2f(W.Z[t * NZ + C_DK + h * 32 + d]) * __expf(-bb);
            SS[idx] = W.GDS[((size_t)(c * 4 + h) * 32) * 64 + idx]; }
        for (int idx = tid; idx < 4096; idx += NT) { const int tok = idx >> 6, v = idx & 63; VS[idx] = bf2f(W.Z[(size_t)(t0 + tok) * NZ + C_DV + h * 64 + v]); }
        __syncthreads();
#pragma unroll
        for (int k = 0; k < 8; ++k) { const int i = wv + 8 * k, jt = lane; float a = 0.f;
            if (jt <= i) {
#pragma unroll
                for (int d = 0; d < 32; ++d) a += QB[i * 33 + d] * KB[jt * 33 + d]; }
            ATT[i * 65 + jt] = a; }
        __syncthreads();
#pragma unroll
        for (int k = 0; k < 8; ++k) { const int i = wv + 8 * k, v = lane; float o = 0.f;
            for (int jt = 0; jt <= i; ++jt) o += ATT[i * 65 + jt] * VS[jt * 64 + v];
#pragma unroll
            for (int d = 0; d < 32; ++d) o += QB[i * 33 + d] * SS[d * 64 + v];
            const float ss = wave_sum(o * o); const size_t t = (size_t)(t0 + i);
            const float y = o * rsqrtf(ss * (1.0f / 64.0f) + EPS) * L.gla_n[h * 64 + v] * siluf_(bf2f(W.Z[t * NZ + C_DR + h * 64 + v]));
            W.Y[t * DM + 768 + h * 64 + v] = (bf16_t)f2bf(y); }
        __syncthreads();
    }
}

typedef float f32x16 __attribute__((ext_vector_type(16)));
template <int MODE, int K>
__device__ __forceinline__ void skinny_unit(LAS unsigned char* lds, const bf16_t* A, const bf16_t* Bt, int n0, void* O, int ldo, const float* rscale, int tid) {
    asm volatile("" : "+v"(tid));
    const int lane = tid & 63, wave = tid >> 6, r = lane & 31, hh = lane >> 5;
    constexpr int KW = K / 8, STEPS = KW / 16;
    const bf16_t* ap = A + (size_t)(TP + r) * K + wave * KW + 8 * hh;
    const bf16_t* bp = Bt + (size_t)(n0 + r) * K + wave * KW + 8 * hh;
    f32x16 acc;
#pragma unroll
    for (int e = 0; e < 16; ++e) acc[e] = 0.f;
#pragma unroll 8
    for (int st = 0; st < STEPS; ++st) { const bf16x8s a = *(const bf16x8s*)(ap + st * 16); const bf16x8s b = *(const bf16x8s*)(bp + st * 16); acc = __builtin_amdgcn_mfma_f32_32x32x16_bf16(a, b, acc, 0, 0, 0); }
    LAS float* RED = (LAS float*)lds;
#pragma unroll
    for (int e = 0; e < 16; ++e) RED[(wave * 16 + e) * 64 + lane] = acc[e];
    __syncthreads();
#pragma unroll
    for (int k = 0; k < 2; ++k) { const int reg = wave * 2 + k; float v = 0.f;
#pragma unroll
        for (int w = 0; w < 8; ++w) v += RED[(w * 16 + reg) * 64 + lane];
        const int row = TP + (reg & 3) + 8 * (reg >> 2) + 4 * hh, col = n0 + r;
        if (MODE == 2) ((float*)O)[(size_t)row * ldo + col] = v;
        else { float x = v * rscale[row]; if (MODE == 1) { x = fmaxf(x, 0.f); x = x * x; } ((bf16_t*)O)[(size_t)row * ldo + col] = (bf16_t)f2bf(x); } }
    __syncthreads();
}

constexpr int PT_OFF = 131072 + 1024;
typedef volatile LAS unsigned long long* PtrTab;
__device__ __forceinline__ unsigned long long pt_ld(PtrTab PT, int i) { const unsigned long long v = PT[i]; const unsigned lo = __builtin_amdgcn_readfirstlane((unsigned)v), hi = __builtin_amdgcn_readfirstlane((unsigned)(v >> 32)); return ((unsigned long long)hi << 32) | lo; }
#define IN_(i) ((const float*)pt_ld(PT, (i)))
#define FRESH_IDS() int tid = threadIdx.x; asm volatile("" : "+v"(tid)); const int lane = tid & 63; const int wave = __builtin_amdgcn_readfirstlane(tid >> 6); const int gw = bid * NWAVES + wave, NGW = G * NWAVES; (void)lane; (void)gw; (void)NGW; \
    unsigned char* ws = (unsigned char*)pt_ld(PT, 30); float* out = (float*)pt_ld(PT, 29); (void)out
__device__ __forceinline__ WsP make_w(unsigned char* ws) {
    WsP W;
    W.XB = (bf16_t*)(ws + WS_XB); W.Z = (bf16_t*)(ws + WS_Z); W.Y = (bf16_t*)(ws + WS_Y); W.U = (bf16_t*)(ws + WS_U); W.MIX = (float*)(ws + WS_MIX);
    W.RSTD = (float*)(ws + WS_RSTD); W.DLR = (float*)(ws + WS_DLR); W.HLOC = (float*)(ws + WS_HLOC); W.PCUM = (float*)(ws + WS_PCUM);
    W.LA = (float*)(ws + WS_LAGG); W.LH = W.LA + 512 * 256; W.HIN = W.LH + 512 * 256;
    W.GDS = (float*)(ws + WS_GDS); W.GDEC = (float*)(ws + WS_GDEC); W.GB = (float*)(ws + WS_GB); W.BIAS = (float*)(ws + WS_BIAS);
    return W;
}
__device__ __forceinline__ LayerP make_l(PtrTab PT, int l) {
    LayerP L;
    L.l = l;
    L.conv_w = IN_(I_CONVW) + l * 1024; L.conv_b = IN_(I_CONVB) + l * 256; L.wa = IN_(I_WA) + l * 16384; L.ba = IN_(I_BA) + l * 256;
    L.wx = IN_(I_WX) + l * 16384; L.bx = IN_(I_BX) + l * 256; L.lam = IN_(I_LAM) + l * 256; L.pool_w = IN_(I_POOLW) + l * 16384; L.pool_s = IN_(I_POOLS) + l * 256;
    L.w_lr = IN_(I_WLR) + l * 2048; L.gla_b = IN_(I_GLAB) + l * 128; L.gla_n = IN_(I_GLAN) + l * 256;
    L.slh = IN_(I_SLH) + (size_t)l * NB * 256; L.slc = IN_(I_SLC) + (size_t)l * NB * 768; L.ck = IN_(I_CK) + (size_t)l * NB * 2048 * 256; L.cv = IN_(I_CV) + (size_t)l * NB * 2048 * 256;
    L.spool = IN_(I_SPOOL) + (size_t)l * NB * 3840; L.sgla = IN_(I_SGLA) + (size_t)l * NB * 8192;
    return L;
}

__global__ void __launch_bounds__(NT, 2) mk_fwd(Args args) {
    extern __shared__ __attribute__((aligned(16))) unsigned char lds_raw[];
    LAS unsigned char* lds = (LAS unsigned char*)lds_raw;
    cg::grid_group grid = cg::this_grid();
    const int G = gridDim.x, bid = blockIdx.x;
    volatile LAS unsigned* MISC = (volatile LAS unsigned*)(lds + MISC_OFF);
    PtrTab PT = (PtrTab)(lds + PT_OFF);
    if (threadIdx.x < 32) MISC[threadIdx.x] = 0u;
    if (threadIdx.x == 64) {
        PT[0] = (unsigned long long)args.in[0]; PT[1] = (unsigned long long)args.in[1]; PT[2] = (unsigned long long)args.in[2]; PT[3] = (unsigned long long)args.in[3];
        PT[4] = (unsigned long long)args.in[4]; PT[5] = (unsigned long long)args.in[5]; PT[6] = (unsigned long long)args.in[6]; PT[7] = (unsigned long long)args.in[7];
        PT[8] = (unsigned long long)args.in[8]; PT[9] = (unsigned long long)args.in[9]; PT[10] = (unsigned long long)args.in[10]; PT[11] = (unsigned long long)args.in[11];
        PT[12] = (unsigned long long)args.in[12]; PT[13] = (unsigned long long)args.in[13]; PT[14] = (unsigned long long)args.in[14]; PT[15] = (unsigned long long)args.in[15];
        PT[16] = (unsigned long long)args.in[16]; PT[17] = (unsigned long long)args.in[17]; PT[18] = (unsigned long long)args.in[18]; PT[19] = (unsigned long long)args.in[19];
        PT[20] = (unsigned long long)args.in[20]; PT[21] = (unsigned long long)args.in[21]; PT[22] = (unsigned long long)args.in[22]; PT[23] = (unsigned long long)args.in[23];
        PT[24] = (unsigned long long)args.in[24]; PT[25] = (unsigned long long)args.in[25]; PT[26] = (unsigned long long)args.in[26]; PT[27] = (unsigned long long)args.in[27];
        PT[28] = (unsigned long long)args.in[28]; PT[29] = (unsigned long long)args.out; PT[30] = (unsigned long long)args.ws;
    }
    __syncthreads();
    XcdBarrier bar = xcd_barrier_post((unsigned*)(args.ws + WS_CTL) + CW_BAR, MISC + 8);

    {
        FRESH_IDS(); const WsP W = make_w(ws);
        LAS float* scr = (LAS float*)(lds + wave * 16384);
        constexpr int I_IN = 16 * (NZ / 32), I_OUT = 16 * 32, I_UP = 16 * (FF / 32), I_DN = 64 * 32, I_L = I_IN + I_OUT + I_UP + I_DN;
        for (int it = gw; it < 2 * I_L; it += NGW) {
            const int l = it / I_L; int r = it % I_L;
            if (r < I_IN) { p0_transpose_item(IN_(I_WIN) + (size_t)l * DM * NIN, NIN, DM, NZ, IN_(I_NPREMIX) + l * DM, (bf16_t*)(ws + WS_WIN) + (size_t)l * NZ * DM, scr, r, lane); continue; } r -= I_IN;
            if (r < I_OUT) { p0_transpose_item(IN_(I_WOUT) + (size_t)l * DM * DM, DM, DM, DM, nullptr, (bf16_t*)(ws + WS_WOUT) + (size_t)l * DM * DM, scr, r, lane); continue; } r -= I_OUT;
            if (r < I_UP) { p0_transpose_item(IN_(I_WUP) + (size_t)l * DM * FF, FF, DM, FF, IN_(I_NPREMLP) + l * DM, (bf16_t*)(ws + WS_WUP) + (size_t)l * FF * DM, scr, r, lane); continue; } r -= I_UP;
            p0_transpose_item(IN_(I_WDOWN) + (size_t)l * FF * DM, DM, FF, DM, nullptr, (bf16_t*)(ws + WS_WDN) + (size_t)l * DM * FF, scr, r, lane);
        }
        { const float* relb = IN_(I_RELB); for (int i = bid * NT + tid; i < 4 * 388; i += G * NT) { const int h = i / 388, s = i % 388; W.BIAS[i] = (s < 387) ? relb[BUCKET[s] * 4 + h] : 0.f; } }
        __syncthreads();
        rowpass<false, true>(lds, IN_(I_XP), IN_(I_XS), nullptr, nullptr, nullptr, IN_(I_NPREMIX), IN_(I_WIN), W.XB, W.RSTD, W.DLR, gw, NGW, tid);
    }
    xcd_barrier(bar);

#pragma unroll 1
    for (int l = 0; l < 2; ++l) {
        {
            FRESH_IDS(); const WsP W = make_w(ws);
            pg8::Gemm g{W.XB, (const bf16_t*)(ws + WS_WIN) + (size_t)l * NZ * DM, TP, NZ, DM}; pg8::StaticOrder S; S.init(TP, NZ, G, bid);
            pg8::EpiScaleBf16<0> E{W.Z, NZ, W.RSTD};
            for (int u = bid; u < NZ / 32; u += G) skinny_unit<0, DM>(lds, W.XB, (const bf16_t*)(ws + WS_WIN) + (size_t)l * NZ * DM, u * 32, W.Z, NZ, W.RSTD, tid);
#ifndef SK_GEMM
            pg8::gemm_phase<pg8::EpiScaleBf16<0>, pg8::StaticOrder, true, true>(lds, g, S, E);
#endif
        }
        xcd_barrier(bar);

        {
            FRESH_IDS(); const WsP W = make_w(ws); const LayerP L = make_l(PT, l);
            for (int tile = bid; tile < 256; tile += G) {
#ifndef SK_LRUL
                lru_local(lds, tile, L, W, out, tid);
#endif
#ifndef SK_GLAL
                gla_local(lds, tile, L, W, tid);
#endif
#ifndef SK_POOL
                pool_tile(lds, tile, L, W, out, tid);
#endif
                vt_repack(lds, tile, W, (bf16_t*)(ws + WS_VT), tid);
 }
#ifndef SK_SAMP
            for (int b = bid; b < NB; b += G) sample_mixers(lds, b, L, W, out, tid);
#endif
            for (int si = gw; si < NB * 4 * 8; si += NGW) attn_sample_part(L, W, (float*)(ws + WS_PART), si, lane);
            for (int i = bid * NT + tid; i < 2 * 2048 * 256; i += G * NT) { const int which = i >> 19, r = (i >> 8) & 2047, c = i & 255;
                out[(which ? O_PV : O_PK) + (size_t)l * 524288 + r * 256 + c] = bf2f(W.Z[(size_t)(TP - 2048 + r) * NZ + (which ? C_BV : C_BK) + c]); }
        }
        xcd_barrier(bar);

        {
            FRESH_IDS(); const WsP W = make_w(ws); LayerP L; L.l = l;
#ifndef SK_SCAN
            for (int it = bid; it < 272; it += G) { if (it < 256) gla_scan_item(lds, it, L, W, out, tid); else lru_scan_item(lds, it - 256, L, W, out, tid); }
#endif
        }
        xcd_barrier(bar);

        {
            FRESH_IDS(); const WsP W = make_w(ws); const LayerP L = make_l(PT, l);
            for (int bh = gw; bh < NB * 4; bh += NGW) attn_sample_combine(W, (const float*)(ws + WS_PART), bh, lane);
#ifndef SK_ATTN
            for (int wi0 = bid * NWAVES; wi0 < 64 * 4 * 16; wi0 += NGW) {
                const int unit = wi0 >> 4, hh = unit & 3, tb = unit >> 2;
                LAS float* BL = (LAS float*)lds;
                for (int i = tid; i < 3 * 640; i += NT) { const int p = i / 640, j = i % 640 - 256; BL[i] = (j >= 0 && j <= 128) ? W.BIAS[hh * 388 + 129 * p + j] : 0.f; }
                __syncthreads();
                attn_mfma_item(BL, W, (const bf16_t*)(ws + WS_VT), hh, tb, (wi0 + wave) & 15, lane);
                __syncthreads();
            }
#endif
            for (int tile = bid; tile < 256; tile += G) {
#ifndef SK_LRUF
                lru_final(tile, L, W, tid);
#endif
#ifndef SK_GLAF
                gla_final(lds, tile, L, W, tid);
#endif
 }
        }
        xcd_barrier(bar);

        {
            FRESH_IDS(); const WsP W = make_w(ws);
            pg8::Gemm g{W.Y, (const bf16_t*)(ws + WS_WOUT) + (size_t)l * DM * DM, TP, DM, DM}; pg8::StaticOrder S; S.init(TP, DM, G, bid);
            for (int u = bid; u < DM / 32; u += G) skinny_unit<2, DM>(lds, W.Y, (const bf16_t*)(ws + WS_WOUT) + (size_t)l * DM * DM, u * 32, W.MIX, DM, nullptr, tid);
            pg8::EpiF32 E{W.MIX, DM};
#ifndef SK_GEMM
            pg8::gemm_phase<pg8::EpiF32, pg8::StaticOrder, true, true>(lds, g, S, E);
#endif
        }
        xcd_barrier(bar);
        {
            FRESH_IDS(); const WsP W = make_w(ws);
            rowpass<true, false>(lds, l == 0 ? IN_(I_XP) : out + O_YP, l == 0 ? IN_(I_XS) : out + O_YS, out, W.MIX, IN_(I_NPOSTMIX) + l * DM, nullptr, nullptr, W.XB, W.RSTD, W.DLR, gw, NGW, tid);
        }
        xcd_barrier(bar);
        {
            FRESH_IDS(); const WsP W = make_w(ws);
            pg8::Gemm g{W.XB, (const bf16_t*)(ws + WS_WUP) + (size_t)l * FF * DM, TP, FF, DM}; pg8::StaticOrder S; S.init(TP, FF, G, bid);
            pg8::EpiScaleBf16<1> E{W.U, FF, W.RSTD};
            for (int u = bid; u < FF / 32; u += G) skinny_unit<1, DM>(lds, W.XB, (const bf16_t*)(ws + WS_WUP) + (size_t)l * FF * DM, u * 32, W.U, FF, W.RSTD, tid);
#ifndef SK_GEMM
            pg8::gemm_phase<pg8::EpiScaleBf16<1>, pg8::StaticOrder, true, true>(lds, g, S, E);
#endif
        }
        xcd_barrier(bar);
        {
            FRESH_IDS(); const WsP W = make_w(ws);
            pg8::Gemm g{W.U, (const bf16_t*)(ws + WS_WDN) + (size_t)l * DM * FF, TP, DM, FF}; pg8::StaticOrder S; S.init(TP, DM, G, bid);
            for (int u = bid; u < DM / 32; u += G) skinny_unit<2, FF>(lds, W.U, (const bf16_t*)(ws + WS_WDN) + (size_t)l * DM * FF, u * 32, W.MIX, DM, nullptr, tid);
            pg8::EpiF32 E{W.MIX, DM};
#ifndef SK_GEMM
            pg8::gemm_phase<pg8::EpiF32, pg8::StaticOrder, true, true>(lds, g, S, E);
#endif
        }
        xcd_barrier(bar);
        {
            FRESH_IDS(); const WsP W = make_w(ws);
#ifndef SK_ROWP
            if (l == 0) rowpass<true, true>(lds, out + O_YP, out + O_YS, out, W.MIX, IN_(I_NPOSTMLP) + l * DM, IN_(I_NPREMIX) + DM, IN_(I_WIN) + (size_t)DM * NIN, W.XB, W.RSTD, W.DLR, gw, NGW, tid);
            else        rowpass<true, false>(lds, out + O_YP, out + O_YS, out, W.MIX, IN_(I_NPOSTMLP) + l * DM, nullptr, nullptr, W.XB, W.RSTD, W.DLR, gw, NGW, tid);
#endif
        }
        if (l == 0) xcd_barrier(bar);
    }
    if (G == 0x7fffffff) grid.sync();
}

extern "C" void kernel_launch(void* const* d_in, const int* in_sizes, int n_in, void* d_out, int out_size, void* d_ws, size_t ws_size, hipStream_t stream) {
    static int grid = 0;
    if (grid == 0) {
        if (n_in != N_INPUTS || out_size != (int)O_END || ws_size < WS_END) { fprintf(stderr, "kernel_launch: unexpected sizes: n_in %d out %d ws %zu\n", n_in, out_size, ws_size); grid = -1; return; }
        int dev = 0, cus = 0, per_cu = 0;
        if (hipGetDevice(&dev) != hipSuccess || hipDeviceGetAttribute(&cus, hipDeviceAttributeMultiprocessorCount, dev) != hipSuccess) { grid = -1; return; }
        if (hipFuncSetAttribute((const void*)mk_fwd, hipFuncAttributeMaxDynamicSharedMemorySize, LDS_BYTES) != hipSuccess) { fprintf(stderr, "kernel_launch: hipFuncSetAttribute failed\n"); grid = -1; return; }
        if (hipOccupancyMaxActiveBlocksPerMultiprocessor(&per_cu, (const void*)mk_fwd, NT, LDS_BYTES) != hipSuccess || per_cu < 1) { fprintf(stderr, "kernel_launch: occupancy query says %d blocks per CU\n", per_cu); grid = -1; return; }
        grid = cus;
    }
    if (grid < 0) return;
    (void)hipMemsetAsync((char*)d_ws + WS_CTL, 0, CTL_ZERO_BYTES, stream);
    Args a{};
    for (int i = 0; i < N_INPUTS; ++i) a.in[i] = (const float*)d_in[i];
    a.out = (float*)d_out; a.ws = (unsigned char*)d_ws;
    void* kargs[] = {&a};
    hipError_t e = hipLaunchCooperativeKernel((const void*)mk_fwd, dim3(grid), dim3(NT), kargs, LDS_BYTES, stream);
    if (e != hipSuccess) fprintf(stderr, "cooperative launch failed: %s (grid %d)\n", hipGetErrorString(e), grid);
}
```

```cpp
#include <hip/hip_runtime.h>
#include <hip/hip_cooperative_groups.h>
#include <cstdio>
#include <cstdint>
namespace cg = cooperative_groups;
namespace pg8 {
#define PG8_LAS __attribute__((address_space(3)))
typedef unsigned short bf16_t;
typedef short bf16x8 __attribute__((ext_vector_type(8)));
typedef float f32x4 __attribute__((ext_vector_type(4)));
typedef unsigned u32x4 __attribute__((ext_vector_type(4)));
constexpr int BM = 256, BK = 64, HALF = 128, HTB = HALF * BK * 2  , STAGE_BYTES = 8 * HTB, NXCD = 8, WGM = 8;

__host__ __device__ __forceinline__ int lds_byte(int r, int c) { const int st = (r >> 4) * 2 + (c >> 5), rr = r & 15, cc = c & 31, ob = rr * 64 + cc * 2; return st * 1024 + (ob ^ (((ob >> 9) & 1) << 5)); }
__host__ __device__ __forceinline__ void stage_rc(int b, int& R, int& C) { const int st = b / 1024, sb = b % 1024, swz = sb ^ (((sb >> 9) & 1) << 5); R = (st >> 1) * 16 + swz / 64; C = (st & 1) * 32 + (swz % 64) / 2; }
__host__ __device__ __forceinline__ int perm32(int rho) { const int n = rho >> 4, i = rho & 15; return 8 * (i >> 2) + 4 * n + (i & 3); }

struct Unit { int pm, pn; };
struct Gemm { const bf16_t* A; const bf16_t* Bt; int M, N, K; };

struct StaticOrder {
    int nM, nN, nwg, G, c;
    __host__ __device__ void init(int M, int N, int G_, int c_) { nM = M / BM; nN = N / BM; nwg = nM * nN; G = G_; c = c_; }
    __host__ __device__ bool next(int i, Unit& u) const {
        const long L = (long)i * G + c; if (L >= nwg) return false;
        int wgid = (int)L; { const int q = nwg / NXCD, r = nwg % NXCD, xcd = wgid % NXCD, off = wgid / NXCD; wgid = (xcd < r ? xcd * (q + 1) : r * (q + 1) + (xcd - r) * q) + off; }
        const int nig = WGM * nN, gid = wgid / nig, fm = gid * WGM, gsz = (nM - fm) < WGM ? (nM - fm) : WGM;
        u.pm = fm + ((wgid % nig) % gsz); u.pn = (wgid % nig) / gsz; return true;
    }
    __device__ __forceinline__ void a_ready(const Unit&) const {}
    __device__ __forceinline__ void done(const Unit&) const {}
};

__device__ __forceinline__ unsigned cvt_pk_bf16(float lo, float hi) { unsigned r; asm volatile("v_cvt_pk_bf16_f32 %0, %1, %2" : "=v"(r) : "v"(lo), "v"(hi)); return r; }
template <int ACT> struct EpiScaleBf16 {
    static constexpr bool PERM = true, AFTER_DRAIN = false;
    bf16_t* O; int ldc; const float* rscale;
    __device__ __forceinline__ void operator()(const f32x4 (&acc)[2][2][4][2], const Unit& u, int wr, int wc, int fr, int fq) const {
        const int row0 = u.pm * BM + wr * 64 + fr; const int col0 = u.pn * BM + wc * 32 + 8 * fq;
#pragma unroll
        for (int ai = 0; ai < 2; ++ai)
#pragma unroll
            for (int m = 0; m < 4; ++m) { const int row = row0 + ai * HALF + m * 16; const float sc = rscale[row]; bf16_t* rowp = O + (size_t)row * ldc + col0;
#pragma unroll
                for (int bj = 0; bj < 2; ++bj) { f32x4 v0 = acc[ai][bj][m][0] * sc, v1 = acc[ai][bj][m][1] * sc;
                    if (ACT == 1) {
#pragma unroll
                        for (int e = 0; e < 4; ++e) { const float a = fmaxf(v0[e], 0.f), b = fmaxf(v1[e], 0.f); v0[e] = a * a; v1[e] = b * b; } }
                    u32x4 w; w.x = cvt_pk_bf16(v0[0], v0[1]); w.y = cvt_pk_bf16(v0[2], v0[3]); w.z = cvt_pk_bf16(v1[0], v1[1]); w.w = cvt_pk_bf16(v1[2], v1[3]);
                    *(u32x4*)(rowp + bj * HALF) = w; } }
    }
};
struct EpiF32 {
    static constexpr bool PERM = true, AFTER_DRAIN = false;
    float* O; int ldc;
    __device__ __forceinline__ void operator()(const f32x4 (&acc)[2][2][4][2], const Unit& u, int wr, int wc, int fr, int fq) const {
        const int row0 = u.pm * BM + wr * 64 + fr; const int col0 = u.pn * BM + wc * 32 + 8 * fq;
#pragma unroll
        for (int ai = 0; ai < 2; ++ai)
#pragma unroll
            for (int m = 0; m < 4; ++m) { float* rowp = O + (size_t)(row0 + ai * HALF + m * 16) * ldc + col0;
#pragma unroll
                for (int bj = 0; bj < 2; ++bj) { *(f32x4*)(rowp + bj * HALF) = acc[ai][bj][m][0]; *(f32x4*)(rowp + bj * HALF + 4) = acc[ai][bj][m][1]; } }
    }
};

template <class Epi, class Sched, bool ALIGN_EPI = false, bool SP2 = false>
__device__ __forceinline__ void gemm_phase(PG8_LAS unsigned char* lds, const Gemm g, const Sched& S, const Epi& E) {
    int tid_l = threadIdx.x; asm volatile("" : "+v"(tid_l));
    const int tid = tid_l, wid = __builtin_amdgcn_readfirstlane(tid >> 6), lane = tid & 63, wr = wid >> 2, wc = wid & 3, fr = lane & 15, fq = lane >> 4;
    const int K = g.K, nt = K / BK;
    unsigned voffA, voffB;
    { int R, C; stage_rc(tid * 16, R, C); const int Rb = Epi::PERM ? ((R & ~31) + perm32(R & 31)) : R;
        voffA = (unsigned)(R * K + C) * 2u; voffB = (unsigned)(Rb * K + C) * 2u; }
    const size_t rstep = (size_t)64 * K * 2;
    const size_t kstep = (size_t)(BK * 2);
    const size_t hstep = (size_t)HALF * K * 2;
    const size_t tstep = 2 * hstep;
    const unsigned ldsw = (unsigned)wid * 1024u;
    const int aoff = lds_byte(wr * 64 + fr, fq * 8), boff = lds_byte(wc * 32 + fr, fq * 8);
#define PG8_SA(b, h) (((b) * 2 + (h)) * HTB)
#define PG8_SB(b, h) ((4 + (b) * 2 + (h)) * HTB)
#define PG8_STAGE(bufoff, gbase, voff) do { _Pragma("unroll") for (int _i = 0; _i < 2; ++_i) \
        __builtin_amdgcn_global_load_lds((const unsigned*)((const char*)(gbase) + (size_t)_i * rstep + (voff)), (PG8_LAS unsigned*)(lds + (bufoff) + ldsw + _i * 8192), 16, 0, 0); } while (0)
#define PG8_LDA(dst, b, h) do { _Pragma("unroll") for (int m = 0; m < 4; ++m) _Pragma("unroll") for (int k = 0; k < 2; ++k) dst[m][k] = *(const PG8_LAS bf16x8*)(lds + PG8_SA(b, h) + aoff + m * 2048 + k * 1024); } while (0)
#define PG8_LDB(dst, b, h) do { _Pragma("unroll") for (int n = 0; n < 2; ++n) _Pragma("unroll") for (int k = 0; k < 2; ++k) dst[n][k] = *(const PG8_LAS bf16x8*)(lds + PG8_SB(b, h) + boff + n * 2048 + k * 1024); } while (0)
#define PG8_MMA(ai, bj, At, Bt) do { __builtin_amdgcn_s_setprio(1); _Pragma("unroll") for (int m = 0; m < 4; ++m) _Pragma("unroll") for (int n = 0; n < 2; ++n) _Pragma("unroll") for (int k = 0; k < 2; ++k) \
        acc[ai][bj][m][n] = __builtin_amdgcn_mfma_f32_16x16x32_bf16(Bt[n][k], At[m][k], acc[ai][bj][m][n], 0, 0, 0); __builtin_amdgcn_s_setprio(0); } while (0)
#define PG8_WAIT_V(n) asm volatile("s_waitcnt vmcnt(" #n ")" ::: "memory")
#define PG8_WAIT_L(n) asm volatile("s_waitcnt lgkmcnt(" #n ")" ::: "memory")
#define PG8_BAR __builtin_amdgcn_s_barrier()
#define PG8_SCHED __builtin_amdgcn_sched_barrier(0)
    Unit cur, nxt; int ui = 0;
    if (!S.next(0, cur)) return;
    f32x4 acc[2][2][4][2];
#pragma unroll
    for (int a = 0; a < 2; ++a)
#pragma unroll
        for (int b = 0; b < 2; ++b)
#pragma unroll
            for (int m = 0; m < 4; ++m)
#pragma unroll
                for (int n = 0; n < 2; ++n) acc[a][b][m][n] = (f32x4){0.f, 0.f, 0.f, 0.f};
    bf16x8 At[4][2], B0[2][2], B1[2][2];
    const char* cA = (const char*)g.A + (size_t)cur.pm * tstep; const char* cB = (const char*)g.Bt + (size_t)cur.pn * tstep;
    S.a_ready(cur);
    if constexpr (SP2) {
        PG8_STAGE(PG8_SB(0, 0), cB, voffB); PG8_STAGE(PG8_SB(0, 1), cB + hstep, voffB); PG8_STAGE(PG8_SA(0, 0), cA, voffA); PG8_STAGE(PG8_SA(0, 1), cA + hstep, voffA);
        if (wr == 1) PG8_BAR;
        PG8_WAIT_V(2); PG8_BAR;
        PG8_STAGE(PG8_SB(1, 0), cB + kstep, voffB); PG8_STAGE(PG8_SA(1, 0), cA + kstep, voffA); PG8_STAGE(PG8_SB(1, 1), cB + hstep + kstep, voffB);
        PG8_WAIT_V(6); PG8_BAR;
    } else {
        PG8_STAGE(PG8_SB(0, 0), cB, voffB); PG8_STAGE(PG8_SA(0, 0), cA, voffA); PG8_STAGE(PG8_SB(0, 1), cB + hstep, voffB); PG8_STAGE(PG8_SA(0, 1), cA + hstep, voffA);
        if (wr == 1) PG8_BAR;
        PG8_WAIT_V(4); PG8_BAR;
        PG8_STAGE(PG8_SB(1, 0), cB + kstep, voffB); PG8_STAGE(PG8_SA(1, 0), cA + kstep, voffA); PG8_STAGE(PG8_SB(1, 1), cB + hstep + kstep, voffB);
        PG8_WAIT_V(6); PG8_BAR;
    }
    for (;;) {
        const bool has_next = S.next(ui + 1, nxt);
        const char* nA = has_next ? (const char*)g.A + (size_t)nxt.pm * tstep : cA; const char* nB = has_next ? (const char*)g.Bt + (size_t)nxt.pn * tstep : cB;
        for (int t = 0; t < nt; t += 2) {
            const bool last = (t == nt - 2);
            const char* a1 = cA + (size_t)(t + 1) * kstep;
            const char* a2 = last ? nA : cA + (size_t)(t + 2) * kstep; const char* b2 = last ? nB : cB + (size_t)(t + 2) * kstep;
            const char* a3 = a2 + kstep; const char* b3 = b2 + kstep;
            if (last && has_next) S.a_ready(nxt);
            if constexpr (SP2) {
            PG8_LDB(B0, 0, 0); PG8_LDB(B1, 0, 1); PG8_SCHED; PG8_LDA(At, 0, 0); PG8_STAGE(PG8_SA(1, 1), a1 + hstep, voffA);
            PG8_WAIT_V(8); PG8_WAIT_L(0); PG8_BAR; PG8_MMA(0, 0, At, B0); PG8_MMA(0, 1, At, B1); PG8_BAR; PG8_SCHED;
            PG8_LDA(At, 0, 1); PG8_STAGE(PG8_SB(0, 0), b2, voffB); PG8_STAGE(PG8_SB(0, 1), b2 + hstep, voffB); PG8_STAGE(PG8_SA(0, 0), a2, voffA);
            PG8_WAIT_V(8); PG8_WAIT_L(0); PG8_BAR; PG8_MMA(1, 0, At, B0); PG8_MMA(1, 1, At, B1); PG8_BAR; PG8_SCHED;
            PG8_LDB(B0, 1, 0); PG8_LDB(B1, 1, 1); PG8_SCHED; PG8_LDA(At, 1, 0); PG8_STAGE(PG8_SA(0, 1), a2 + hstep, voffA);
            PG8_WAIT_V(8); PG8_WAIT_L(0); PG8_BAR; PG8_MMA(0, 0, At, B0); PG8_MMA(0, 1, At, B1); PG8_BAR; PG8_SCHED;
            PG8_LDA(At, 1, 1); PG8_STAGE(PG8_SB(1, 0), b3, voffB); PG8_STAGE(PG8_SB(1, 1), b3 + hstep, voffB); PG8_STAGE(PG8_SA(1, 0), a3, voffA);
            PG8_WAIT_V(8); PG8_WAIT_L(0); PG8_BAR; PG8_MMA(1, 0, At, B0); PG8_MMA(1, 1, At, B1); PG8_BAR; PG8_SCHED;
            } else {
            PG8_LDB(B0, 0, 0); PG8_SCHED; PG8_LDA(At, 0, 0); PG8_STAGE(PG8_SA(1, 1), a1 + hstep, voffA);
            PG8_WAIT_L(8); PG8_BAR; PG8_WAIT_L(0); PG8_MMA(0, 0, At, B0); PG8_BAR; PG8_SCHED;
            PG8_LDB(B1, 0, 1); PG8_STAGE(PG8_SB(0, 0), b2, voffB);
            PG8_BAR; PG8_WAIT_L(0); PG8_MMA(0, 1, At, B1); PG8_BAR;
            PG8_LDA(At, 0, 1); PG8_STAGE(PG8_SA(0, 0), a2, voffA);
            PG8_BAR; PG8_WAIT_L(0); PG8_MMA(1, 0, At, B0); PG8_BAR; PG8_SCHED;
            PG8_STAGE(PG8_SB(0, 1), b2 + hstep, voffB);
            PG8_WAIT_V(6); PG8_BAR; PG8_MMA(1, 1, At, B1); PG8_BAR;
            PG8_LDB(B0, 1, 0); PG8_SCHED; PG8_LDA(At, 1, 0); PG8_STAGE(PG8_SA(0, 1), a2 + hstep, voffA);
            PG8_WAIT_L(8); PG8_BAR; PG8_WAIT_L(0); PG8_MMA(0, 0, At, B0); PG8_BAR; PG8_SCHED;
            PG8_LDB(B1, 1, 1); PG8_STAGE(PG8_SB(1, 0), b3, voffB);
            PG8_BAR; PG8_WAIT_L(0); PG8_MMA(0, 1, At, B1); PG8_BAR;
            PG8_LDA(At, 1, 1); PG8_STAGE(PG8_SA(1, 0), a3, voffA);
            PG8_BAR; PG8_WAIT_L(0); PG8_MMA(1, 0, At, B0); PG8_BAR; PG8_SCHED;
            PG8_STAGE(PG8_SB(1, 1), b3 + hstep, voffB);
            PG8_WAIT_V(6); PG8_BAR; PG8_MMA(1, 1, At, B1); PG8_BAR;
            }
        }
        if constexpr (ALIGN_EPI) { if (wr == 0) PG8_BAR; }
        if constexpr (!Epi::AFTER_DRAIN) { E(acc, cur, wr, wc, fr, fq); S.done(cur); }
        if (!has_next) break;
#pragma unroll
        for (int a = 0; a < 2; ++a)
#pragma unroll
            for (int b = 0; b < 2; ++b)
#pragma unroll
                for (int m = 0; m < 4; ++m)
#pragma unroll
                    for (int n = 0; n < 2; ++n) acc[a][b][m][n] = (f32x4){0.f, 0.f, 0.f, 0.f};
        cur = nxt; cA = nA; cB = nB; ++ui;
        if constexpr (ALIGN_EPI) { if (wr == 1) PG8_BAR; }
    }
    PG8_WAIT_V(0);
    if constexpr (!ALIGN_EPI) { if (wr == 0) PG8_BAR; }
    PG8_BAR;
    if constexpr (Epi::AFTER_DRAIN) { E.fused(acc, cur, wr, wc, fr, fq, lds, wid, lane); S.done(cur); }
#undef PG8_SA
#undef PG8_SB
#undef PG8_STAGE
#undef PG8_LDA
#undef PG8_LDB
#undef PG8_MMA
#undef PG8_WAIT_V
#undef PG8_WAIT_L
#undef PG8_BAR
#undef PG8_SCHED
}
}

#define GAS __attribute__((address_space(1)))
#define LAS __attribute__((address_space(3)))
typedef unsigned short bf16_t;
typedef float f32x4 __attribute__((ext_vector_type(4)));
typedef unsigned u32x4 __attribute__((ext_vector_type(4)));
typedef unsigned u32x2 __attribute__((ext_vector_type(2)));

constexpr int NT = 512, NWAVES = 8;
constexpr int DM = 1024, TP = 16384, NB = 32, MROWS = 16640, NROWS = TP + NB, NZ = 2304, NIN = 2320, FF = 4096;
constexpr float EPS = 1e-6f;
constexpr int C_AU = 0, C_AG = 256, C_BQ = 512, C_BK = 768, C_BV = 1024, C_CU = 1280, C_DQ = 1536, C_DK = 1664, C_DV = 1792, C_DR = 2048;
enum { I_XP = 0, I_XS, I_SLH, I_SLC, I_CK, I_CV, I_SPOOL, I_SGLA, I_NPREMIX, I_NPOSTMIX, I_NPREMLP, I_NPOSTMLP, I_WIN, I_CONVW, I_CONVB, I_WA, I_BA, I_WX, I_BX, I_LAM, I_RELB, I_POOLW, I_POOLS, I_WLR, I_GLAB, I_GLAN, I_WOUT, I_WUP, I_WDOWN, N_INPUTS };
constexpr size_t O_YP = 0, O_YS = O_YP + (size_t)TP * DM, O_PH = O_YS + NB * DM, O_PC = O_PH + 2 * 256, O_PK = O_PC + 2 * 3 * 256, O_PV = O_PK + 2 * 2048 * 256,
                 O_PP = O_PV + 2 * 2048 * 256, O_PG = O_PP + 2 * 15 * 256, O_SH = O_PG + 2 * 8192, O_SC = O_SH + 2 * NB * 256, O_SK = O_SC + 2 * NB * 3 * 256,
                 O_SV = O_SK + 2 * NB * 256, O_SP = O_SV + 2 * NB * 256, O_SG = O_SP + 2 * NB * 15 * 256, O_END = O_SG + 2 * NB * 8192;
static_assert(O_END == 19801600, "output size");
constexpr size_t MiB = 1u << 20;
constexpr size_t WS_CTL = 0, CTL_ZERO_BYTES = 1 * MiB;
constexpr size_t WS_WIN = 2 * MiB, WS_WOUT = 11 * MiB, WS_WUP = 15 * MiB, WS_WDN = 31 * MiB;
constexpr size_t WS_XB = 47 * MiB, WS_Z = 80 * MiB, WS_Y = 154 * MiB, WS_MIX = 187 * MiB, WS_U = 252 * MiB;
constexpr size_t WS_RSTD = 382 * MiB, WS_DLR = 383 * MiB, WS_HLOC = 385 * MiB, WS_PCUM = 401 * MiB, WS_LAGG = 417 * MiB;
constexpr size_t WS_GDS = 419 * MiB, WS_GDEC = 427 * MiB, WS_GB = 428 * MiB, WS_BIAS = 436 * MiB, WS_PART = 437 * MiB, WS_VT = 438 * MiB, WS_DVT = 463 * MiB, WS_ST = 472 * MiB, WS_END = 477 * MiB;
constexpr int CW_BAR = 4096;
constexpr int LDS_BYTES = 147456, MISC_OFF = 131072 + 320;

__constant__ unsigned char BUCKET[387] = {
0,1,2,3,4,5,6,7,8,9,10,11,12,13,14,15,16,16,16,16,16,16,17,17,17,17,17,17,17,17,18,18,18,18,18,18,18,18,18,18,19,19,19,19,19,19,19,19,19,19,19,19,19,19,20,20,20,20,20,20,20,20,20,20,20,20,20,20,20,20,20,20,20,21,21,21,21,21,21,21,21,21,21,21,21,21,21,21,21,21,21,21,21,21,21,21,21,21,21,22,22,22,22,22,22,22,22,22,22,22,22,22,22,22,22,22,22,22,22,22,22,22,22,22,22,22,22,22,22,
0,4,8,12,16,16,17,17,18,18,19,19,19,19,20,20,20,20,20,21,21,21,21,21,21,22,22,22,22,22,22,22,22,22,23,23,23,23,23,23,23,23,23,23,23,23,24,24,24,24,24,24,24,24,24,24,24,24,24,24,24,24,25,25,25,25,25,25,25,25,25,25,25,25,25,25,25,25,25,25,25,25,25,26,26,26,26,26,26,26,26,26,26,26,26,26,26,26,26,26,26,26,26,26,26,26,26,26,26,26,26,26,26,27,27,27,27,27,27,27,27,27,27,27,27,27,27,27,27,
0,16,18,19,20,21,21,22,22,23,23,23,24,24,24,24,25,25,25,25,25,26,26,26,26,26,26,26,26,27,27,27,27,27,27,27,27,27,27,28,28,28,28,28,28,28,28,28,28,28,28,28,29,29,29,29,29,29,29,29,29,29,29,29,29,29,29,29,29,29,30,30,30,30,30,30,30,30,30,30,30,30,30,30,30,30,30,30,30,30,30,30,30,30,30,31,31,31,31,31,31,31,31,31,31,31,31,31,31,31,31,31,31,31,31,31,31,31,31,31,31,31,31,31,31,31,31,31,31};

#define XB_TMO      128
#define XB_XCNT(j)  (256  + 64 * (j))
#define XB_XSUB(j)  (1280 + 64 * (j))
#define XB_XGEN(j)  (2304 + 64 * (j))
#define XB_TOP      3328
#define XB_TOPGEN   3392
#define XCD_BAR_WORDS 3456
#define XB_SPIN_CAP (1u << 18)
__device__ __forceinline__ unsigned xb_ld(unsigned* p)              { return __hip_atomic_load(p, __ATOMIC_RELAXED, __HIP_MEMORY_SCOPE_AGENT); }
__device__ __forceinline__ unsigned xb_add(unsigned* p, unsigned v) { return __hip_atomic_fetch_add(p, v, __ATOMIC_RELAXED, __HIP_MEMORY_SCOPE_AGENT); }
__device__ __forceinline__ unsigned xb_xcc_id() { return (unsigned)__builtin_amdgcn_s_getreg((3 << 11) | 20) & 0xFu; }
#define XB_SPIN(cond, bar) do { unsigned _sp = 0; while (cond) { __builtin_amdgcn_s_sleep(1); \
    if ((++_sp & 255u) == 0u) { if (xb_ld(&(bar)[XB_TMO])) break; if (_sp > XB_SPIN_CAP) { atomicAdd(&(bar)[XB_TMO], 1u); break; } } } } while (0)
struct XcdBarrier { unsigned* bar; unsigned x; volatile LAS unsigned* st; };
__device__ __forceinline__ XcdBarrier xcd_barrier_post(unsigned* bar, volatile LAS unsigned* st) {
    XcdBarrier b; b.bar = bar; b.x = xb_xcc_id(); b.st = st;
    if (threadIdx.x == 0) (void)xb_add(&bar[XB_XCNT(b.x)], 1u);
    return b;
}
__device__ __forceinline__ void xcd_barrier_complete(unsigned* bar, unsigned x, unsigned& nloc, unsigned& nx) {
    const unsigned G = gridDim.x * gridDim.y * gridDim.z;
    unsigned sum, cnt, mine, sp = 0u;
    for (;;) {
        sum = 0u; cnt = 0u; mine = 0u;
#pragma unroll
        for (unsigned j = 0; j < 16; ++j) { const unsigned c = xb_ld(&bar[XB_XCNT(j)]); sum += c; cnt += (c > 0u) ? 1u : 0u; mine = (j == x) ? c : mine; }
        if (sum == G) break;
        __builtin_amdgcn_s_sleep(1);
        if ((++sp & 255u) == 0u) { if (xb_ld(&bar[XB_TMO])) break; if (sp > XB_SPIN_CAP) { atomicAdd(&bar[XB_TMO], 1u); break; } }
    }
    nloc = mine > 0u ? mine : 1u; nx = cnt > 0u ? cnt : 1u;
}
__device__ __forceinline__ void xcd_barrier(const XcdBarrier& b) {
    asm volatile("s_waitcnt vmcnt(0)" ::: "memory");
    __syncthreads();
    if (threadIdx.x == 0) {
        unsigned* bar = b.bar;
        __builtin_amdgcn_s_waitcnt(0);
        unsigned nloc = b.st[0], nx = b.st[1];
        if (nloc == 0u) { xcd_barrier_complete(bar, b.x, nloc, nx); b.st[0] = nloc; b.st[1] = nx; }
        const unsigned old = xb_add(&bar[XB_XSUB(b.x)], 1u);
        const unsigned gen = old / nloc;
        if (old + 1u == (gen + 1u) * nloc) {
            __builtin_amdgcn_fence(__ATOMIC_RELEASE, "agent");
            asm volatile("s_waitcnt vmcnt(0)" ::: "memory");
            const unsigned og = xb_add(&bar[XB_TOP], 1u);
            const unsigned tg = og / nx;
            if (og + 1u == (tg + 1u) * nx) xb_add(&bar[XB_TOPGEN], 1u);
            else XB_SPIN(xb_ld(&bar[XB_TOPGEN]) == tg, bar);
            __builtin_amdgcn_fence(__ATOMIC_ACQUIRE, "agent");
            xb_add(&bar[XB_XGEN(b.x)], 1u);
            asm volatile("s_waitcnt vmcnt(0)" ::: "memory");
        } else {
            XB_SPIN(xb_ld(&bar[XB_XGEN(b.x)]) == gen, bar);
            __builtin_amdgcn_fence(__ATOMIC_ACQUIRE, "agent");
            asm volatile("s_waitcnt vmcnt(0)" ::: "memory");
        }
    }
    __syncthreads();
}

#define LDS_WAIT() asm volatile("s_waitcnt lgkmcnt(0)" ::: "memory")
__device__ __forceinline__ float bf2f(bf16_t b) { return __uint_as_float((unsigned)b << 16); }
__device__ __forceinline__ float bflo(unsigned w) { return __uint_as_float(w << 16); }
__device__ __forceinline__ float bfhi(unsigned w) { return __uint_as_float(w & 0xffff0000u); }
__device__ __forceinline__ unsigned f2bf(float f) { unsigned u = __float_as_uint(f); return (u + 0x7fffu + ((u >> 16) & 1u)) >> 16; }
__device__ __forceinline__ unsigned pk2(float lo, float hi) { return f2bf(lo) | (f2bf(hi) << 16); }
__device__ __forceinline__ float wave_sum(float v) {
#pragma unroll
    for (int o = 1; o < 64; o <<= 1) v += __shfl_xor(v, o);
    return v;
}
__device__ __forceinline__ float wave_max(float v) {
#pragma unroll
    for (int o = 1; o < 64; o <<= 1) v = fmaxf(v, __shfl_xor(v, o));
    return v;
}
__device__ __forceinline__ float sigmoidf_(float x) { return 1.0f / (1.0f + __expf(-x)); }
__device__ __forceinline__ float logsigmoidf_(float x) { return fminf(x, 0.f) - log1pf(__expf(-fabsf(x))); }
__device__ __forceinline__ float gelu_tanh(float x) { const float u = 0.7978845608028654f * (x + 0.044715f * x * x * x); return 0.5f * x * (1.0f + tanhf(u)); }
__device__ __forceinline__ float siluf_(float x) { return x / (1.0f + __expf(-x)); }

struct Args { const float* in[N_INPUTS]; float* out; unsigned char* ws; };

__device__ __forceinline__ void p0_transpose_item(const float* W, int ldw, int K, int Ncols, const float* kscale, bf16_t* WT, LAS float* scr, int item, int lane) {
    const int nblk = Ncols / 32, kb = item / nblk, nb = item % nblk, k0 = 64 * kb, n0 = 32 * nb;
#pragma unroll 8
    for (int i = 0; i < 32; ++i) { const int kk = 2 * i + (lane >> 5); const float s = kscale ? kscale[k0 + kk] : 1.0f; scr[kk * 33 + (lane & 31)] = W[(size_t)(k0 + kk) * ldw + n0 + (lane & 31)] * s; }
    LDS_WAIT(); asm volatile("" ::: "memory");
    const int c = lane & 7;
#pragma unroll
    for (int j = 0; j < 4; ++j) { const int n = (lane >> 3) + 8 * j; const LAS float* s = scr + (8 * c) * 33 + n;
        u32x4 o; o.x = pk2(s[0 * 33], s[1 * 33]); o.y = pk2(s[2 * 33], s[3 * 33]); o.z = pk2(s[4 * 33], s[5 * 33]); o.w = pk2(s[6 * 33], s[7 * 33]);
        *(u32x4*)(WT + (size_t)(n0 + n) * K + k0 + 8 * c) = o; }
    LDS_WAIT(); asm volatile("" ::: "memory");
}

template <bool HAS_MIX, bool WANT_DLR>
__device__ __forceinline__ void rowpass(LAS unsigned char* lds, const float* xsrcP, const float* xsrcS, float* xdst, const float* mix, const float* gpost,
                                        const float* gpre_next, const float* win_next, bf16_t* XB, float* RSTD, float* DLR, int gw, int NGW, int tid) {
    const int lane = tid & 63;
    LAS float* WLT = (LAS float*)lds;
    if (WANT_DLR) {
        for (int idx = tid; idx < 16384; idx += NT) { const int k = idx >> 4, j = idx & 15; WLT[j * 1028 + k] = gpre_next[k] * win_next[(size_t)k * NIN + NZ + j]; }
        __syncthreads();
    }
    for (int row = gw; row < NROWS; row += NGW) {
        const float* xs = (row < TP) ? xsrcP + (size_t)row * DM : xsrcS + (size_t)(row - TP) * DM;
        f32x4 v[4];
#pragma unroll
        for (int j = 0; j < 4; ++j) v[j] = *(const f32x4*)(xs + 4 * lane + 256 * j);
        if (HAS_MIX) {
            f32x4 mv[4]; float s = 0.f;
#pragma unroll
            for (int j = 0; j < 4; ++j) { mv[j] = *(const f32x4*)(mix + (size_t)row * DM + 4 * lane + 256 * j); s += (mv[j].x * mv[j].x + mv[j].y * mv[j].y) + (mv[j].z * mv[j].z + mv[j].w * mv[j].w); }
            const float rm = rsqrtf(wave_sum(s) * (1.0f / DM) + EPS);
#pragma unroll
            for (int j = 0; j < 4; ++j) { const f32x4 g = *(const f32x4*)(gpost + 4 * lane + 256 * j); v[j] = v[j] + mv[j] * rm * g; }
        }
        if (xdst) {
#pragma unroll
            for (int j = 0; j < 4; ++j) *(f32x4*)(xdst + (size_t)row * DM + 4 * lane + 256 * j) = v[j];
        }
        float s2 = 0.f;
#pragma unroll
        for (int j = 0; j < 4; ++j) s2 += (v[j].x * v[j].x + v[j].y * v[j].y) + (v[j].z * v[j].z + v[j].w * v[j].w);
        const float rstd = rsqrtf(wave_sum(s2) * (1.0f / DM) + EPS);
        if (lane == 0) RSTD[row] = rstd;
#pragma unroll
        for (int j = 0; j < 4; ++j) { u32x2 w; w.x = pk2(v[j].x, v[j].y); w.y = pk2(v[j].z, v[j].w); *(u32x2*)(XB + (size_t)row * DM + 4 * lane + 256 * j) = w; }
        if (WANT_DLR) {
            float mine = 0.f; int lo = 4 * lane; asm volatile("" : "+v"(lo));
#pragma unroll
            for (int jj = 0; jj < 16; ++jj) {
                float a = 0.f;
#pragma unroll
                for (int j = 0; j < 4; ++j) { const f32x4 w = *(const LAS f32x4*)(WLT + jj * 1028 + lo + 256 * j); a += (v[j].x * w.x + v[j].y * w.y) + (v[j].z * w.z + v[j].w * w.w); }
                a = wave_sum(a);
                if ((lo >> 2) == jj) mine = a;
            }
            if (lane < 16) DLR[(size_t)row * 16 + lane] = mine * rstd;
        }
    }
    if (WANT_DLR) __syncthreads();
}

struct LayerP {
    const float *conv_w, *conv_b, *wa, *ba, *wx, *bx, *lam, *pool_w, *pool_s, *w_lr, *gla_b, *gla_n;
    const float *slh, *slc, *ck, *cv, *spool, *sgla;
    int l;
};
struct WsP { bf16_t *XB, *Z, *Y, *U; float *MIX, *RSTD, *DLR, *HLOC, *PCUM, *LA, *LH, *HIN, *GDS, *GDEC, *GB, *BIAS; };

constexpr int XS = 68;

__device__ __forceinline__ void lru_local(LAS unsigned char* lds, int tile, const LayerP& L, const WsP& W, float* out, int tid) {
    asm volatile("" : "+v"(tid));
    LAS float* XT = (LAS float*)lds;
    const int ch = tid & 255, half = tid >> 8, h = ch >> 6, j = ch & 63;
    const int t0 = tile * 64 + half * 32;
    const bf16_t* zc = W.Z + C_AU + ch;
    const float w0 = L.conv_w[ch], w1 = L.conv_w[256 + ch], w2 = L.conv_w[512 + ch], w3 = L.conv_w[768 + ch], cb = L.conv_b[ch];
    float am3 = (t0 >= 3) ? bf2f(zc[(size_t)(t0 - 3) * NZ]) : 0.f, am2 = (t0 >= 3) ? bf2f(zc[(size_t)(t0 - 2) * NZ]) : 0.f, am1 = (t0 >= 3) ? bf2f(zc[(size_t)(t0 - 1) * NZ]) : 0.f;
#pragma unroll
    for (int tok = 0; tok < 32; ++tok) { const float a0 = bf2f(zc[(size_t)(t0 + tok) * NZ]); const float uu = cb + w0 * am3 + w1 * am2 + w2 * am1 + w3 * a0; am3 = am2; am2 = am1; am1 = a0;
        XT[ch * XS + half * 32 + tok] = uu; }
    if (tile == 255 && half == 1) { float* o = out + O_PC + (size_t)L.l * 768 + ch; o[0] = am3; o[256] = am2; o[512] = am1; }
    __syncthreads();
    const float* wa = L.wa + h * 4096 + j; const float* wx = L.wx + h * 4096 + j;
    const float ba = L.ba[ch], bx = L.bx[ch], c8 = -8.0f * log1pf(__expf(-L.lam[ch]));
    float P = 1.f, hl = 0.f;
    int ch2 = ch; asm volatile("" : "+v"(ch2));
    float* hp = W.HLOC + (size_t)t0 * 256 + ch2; float* pp = W.PCUM + (size_t)t0 * 256 + ch2;
    const LAS float* up = XT + ch2 * XS + half * 32;
#pragma unroll 1
    for (int hf = 0; hf < 2; ++hf) {
        float r[16], gi[16];
#pragma unroll
        for (int tok = 0; tok < 16; ++tok) { r[tok] = 0.f; gi[tok] = 0.f; }
        float wa_c[8], wx_c[8], wa_n[8], wx_n[8];
#pragma unroll
        for (int k = 0; k < 8; ++k) { wa_c[k] = wa[k * 64]; wx_c[k] = wx[k * 64]; }
#pragma unroll 1
        for (int ib = 0; ib < 64; ib += 8) {
            const int ibn = (ib + 8 < 64) ? ib + 8 : ib;
#pragma unroll
            for (int k = 0; k < 8; ++k) { wa_n[k] = wa[(ibn + k) * 64]; wx_n[k] = wx[(ibn + k) * 64]; }
#pragma unroll
            for (int k = 0; k < 8; ++k) {
                const float a_ = wa_c[k], x_ = wx_c[k];
                const LAS f32x4* xr = (const LAS f32x4*)(XT + (h * 64 + ib + k) * XS + half * 32 + hf * 16);
#pragma unroll
                for (int q = 0; q < 4; ++q) { const f32x4 xv = xr[q];
#pragma unroll
                    for (int e = 0; e < 4; ++e) { r[4 * q + e] += xv[e] * a_; gi[4 * q + e] += xv[e] * x_; } }
            }
#pragma unroll
            for (int k = 0; k < 8; ++k) { wa_c[k] = wa_n[k]; wx_c[k] = wx_n[k]; }
        }
#pragma unroll
        for (int tok = 0; tok < 16; ++tok) {
            const float rr = sigmoidf_(r[tok] + ba), gg = sigmoidf_(gi[tok] + bx), la = c8 * rr, a = __expf(la);
            const float inp = sqrtf(-expm1f(2.0f * la)) * (gg * up[hf * 16 + tok]);
            hl = a * hl + inp; P *= a;
            hp[(hf * 16 + tok) * 256] = hl; pp[(hf * 16 + tok) * 256] = P;
        }
    }
    const int seg = tile * 2 + half;
    W.LA[seg * 256 + ch2] = P; W.LH[seg * 256 + ch2] = hl;
    __syncthreads();
}

__device__ __forceinline__ void gla_local(LAS unsigned char* lds, int c, const LayerP& L, const WsP& W, int tid) {
    asm volatile("" : "+v"(tid));
    LAS float* Bc = (LAS float*)lds;
    LAS float* Kd = Bc + 8192;
    LAS float* Vs = Kd + 8192;
    const int t0 = c * 64;
    {
        const int n = tid & 127, q = tid >> 7;
        float wl[16];
#pragma unroll
        for (int jj = 0; jj < 16; ++jj) wl[jj] = L.w_lr[jj * 128 + n];
        const float gb = L.gla_b[n];
        for (int tt = 0; tt < 16; ++tt) { const int tok = q * 16 + tt; const float* d = W.DLR + (size_t)(t0 + tok) * 16; float a = gb;
#pragma unroll
            for (int jj = 0; jj < 16; ++jj) a += d[jj] * wl[jj];
            Bc[tok * 128 + n] = logsigmoidf_(a) * (1.0f / 16.0f); }
    }
    __syncthreads();
    if (tid < 128) { float s = 0.f; for (int tok = 0; tok < 64; ++tok) { s += Bc[tok * 128 + tid]; Bc[tok * 128 + tid] = s; W.GB[(size_t)(t0 + tok) * 128 + tid] = s; } }
    for (int idx = tid; idx < 64 * 16; idx += NT) { const int tok = idx >> 4, c8 = idx & 15; const u32x4 v = *(const u32x4*)(W.Z + (size_t)(t0 + tok) * NZ + C_DK + c8 * 8); LAS float* o = Kd + tok * 128 + c8 * 8;
        o[0] = bflo(v.x); o[1] = bfhi(v.x); o[2] = bflo(v.y); o[3] = bfhi(v.y); o[4] = bflo(v.z); o[5] = bfhi(v.z); o[6] = bflo(v.w); o[7] = bfhi(v.w); }
    for (int idx = tid; idx < 64 * 32; idx += NT) { const int tok = idx >> 5, c8 = idx & 31; const u32x4 v = *(const u32x4*)(W.Z + (size_t)(t0 + tok) * NZ + C_DV + c8 * 8); LAS float* o = Vs + tok * 256 + c8 * 8;
        o[0] = bflo(v.x); o[1] = bfhi(v.x); o[2] = bflo(v.y); o[3] = bfhi(v.y); o[4] = bflo(v.z); o[5] = bfhi(v.z); o[6] = bflo(v.w); o[7] = bfhi(v.w); }
    __syncthreads();
    for (int idx = tid; idx < 8192; idx += NT) { const int n = idx & 127; Kd[idx] *= __expf(Bc[63 * 128 + n] - Bc[idx]); }
    __syncthreads();
    {
        const int h = tid >> 7, dk = (tid & 127) >> 2, dv0 = (tid & 3) * 16;
        float acc[16];
#pragma unroll
        for (int e = 0; e < 16; ++e) acc[e] = 0.f;
        for (int jt = 0; jt < 64; ++jt) { const float kd = Kd[jt * 128 + h * 32 + dk]; const LAS f32x4* vp = (const LAS f32x4*)(Vs + jt * 256 + h * 64 + dv0);
#pragma unroll
            for (int q = 0; q < 4; ++q) { const f32x4 vv = vp[q];
#pragma unroll
                for (int e = 0; e < 4; ++e) acc[4 * q + e] += kd * vv[e]; } }
        float* o = W.GDS + ((size_t)(c * 4 + h) * 32 + dk) * 64 + dv0;
#pragma unroll
        for (int q = 0; q < 4; ++q) *(f32x4*)(o + 4 * q) = (f32x4){acc[4 * q], acc[4 * q + 1], acc[4 * q + 2], acc[4 * q + 3]};
        if ((tid & 3) == 0) W.GDEC[c * 128 + h * 32 + dk] = __expf(Bc[63 * 128 + h * 32 + dk]);
    }
    __syncthreads();
}

__device__ __forceinline__ void pool_tile(LAS unsigned char* lds, int tile, const LayerP& L, const WsP& W, float* out, int tid) {
    asm volatile("" : "+v"(tid));
    LAS float* PT = (LAS float*)lds;
    LAS bf16_t* CU = (LAS bf16_t*)(lds + 256 * XS * 4);
    const int t0 = tile * 64;
    for (int idx = tid; idx < 79 * 32; idx += NT) { const int r = idx >> 5, c8 = idx & 31; const int t = t0 - 15 + r;
        u32x4 v = (u32x4){0u, 0u, 0u, 0u}; if (t >= 0) v = *(const u32x4*)(W.Z + (size_t)t * NZ + C_CU + c8 * 8);
        *(LAS u32x4*)(CU + r * 256 + c8 * 8) = v; }
    __syncthreads();
    const int ch = tid & 255, half = tid >> 8, g = ch >> 6, w = 2 << g;
    if (tile == 255) { for (int r = 64 + half; r < 79; r += 2) out[O_PP + (size_t)L.l * 3840 + (r - 64) * 256 + ch] = bf2f(CU[r * 256 + ch]); }
    for (int tok = 0; tok < 32; ++tok) { const int tl = half * 32 + tok, t = t0 + tl; float s = 0.f;
        for (int i = 0; i < w; ++i) s += bf2f(CU[(15 + tl - i) * 256 + ch]);
        const float cnt = (float)((t + 1 < w) ? (t + 1) : w);
        PT[ch * XS + tl] = s / cnt - bf2f(CU[(15 + tl) * 256 + ch]); }
    __syncthreads();
    float acc[32];
#pragma unroll
    for (int tok = 0; tok < 32; ++tok) acc[tok] = 0.f;
    const float* wp = L.pool_w + g * 4096 + (ch & 63);
    float wv[64];
#pragma unroll
    for (int i = 0; i < 64; ++i) wv[i] = wp[i * 64];
#pragma unroll
    for (int i = 0; i < 64; ++i) { const float w_ = wv[i]; const LAS f32x4* xr = (const LAS f32x4*)(PT + (g * 64 + i) * XS + half * 32);
#pragma unroll
        for (int q = 0; q < 8; ++q) { const f32x4 xv = xr[q];
#pragma unroll
            for (int e = 0; e < 4; ++e) acc[4 * q + e] += xv[e] * w_; } }
    const float sc = L.pool_s[ch];
    int ch2 = ch; asm volatile("" : "+v"(ch2));
    bf16_t* yp = W.Y + (size_t)(t0 + half * 32) * DM + 512 + ch2;
#pragma unroll
    for (int tok = 0; tok < 32; ++tok) yp[tok * DM] = (bf16_t)f2bf(acc[tok] * sc);
    __syncthreads();
}

__device__ __forceinline__ void unpack8(const u32x4 v, float* d) { d[0] = bflo(v.x); d[1] = bfhi(v.x); d[2] = bflo(v.y); d[3] = bfhi(v.y); d[4] = bflo(v.z); d[5] = bfhi(v.z); d[6] = bflo(v.w); d[7] = bfhi(v.w); }

typedef short bf16x8s __attribute__((ext_vector_type(8)));
constexpr int VT_LDS_STRIDE = 258;
template <int SRC_COL, int NPAT>
__device__ __forceinline__ void vt_repack(LAS unsigned char* lds, int tile, const WsP& W, bf16_t* VT, int tid) {
    asm volatile("" : "+v"(tid));
    LAS bf16_t* VL = (LAS bf16_t*)lds;
    const int t0 = tile * 64;
    for (int idx = tid; idx < 64 * 128; idx += NT) { const int tok = idx >> 7, c2 = idx & 127;
        *(LAS unsigned*)(VL + tok * VT_LDS_STRIDE + 2 * c2) = *(const unsigned*)(W.Z + (size_t)(t0 + tok) * NZ + SRC_COL + 2 * c2); }
    __syncthreads();
#pragma unroll 4
    for (int k = 0; k < 8 * NPAT; ++k) {
        const int idx = tid + NT * k, p = idx >> 12, rem = idx & 4095, c = rem & 255, gq = rem >> 8;
        const int d = 1 << (2 * p);
        const int tb = (p == 0) ? 4 * gq : ((p == 1) ? (gq & 3) + 16 * (gq >> 2) : gq);
        const int di = (p == 0) ? t0 + 4 * gq : ((p == 1) ? (gq & 3) * (TP / 4) + t0 / 4 + 4 * (gq >> 2) : gq * (TP / 16) + t0 / 16);
        const unsigned e0 = VL[(tb) * VT_LDS_STRIDE + c], e1 = VL[(tb + d) * VT_LDS_STRIDE + c], e2 = VL[(tb + 2 * d) * VT_LDS_STRIDE + c], e3 = VL[(tb + 3 * d) * VT_LDS_STRIDE + c];
        u32x2 w; w.x = e0 | (e1 << 16); w.y = e2 | (e3 << 16);
        *(u32x2*)(VT + ((size_t)(p * 256 + c)) * TP + di) = w;
    }
    __syncthreads();
}
struct AttnFrag { bf16x8s k[2][2]; u32x2 v[4][2]; };
template <int P>
__device__ __forceinline__ AttnFrag attn_load(const bf16_t* Zk, const bf16_t* VTp, int ub0, int r, int pr, int q, int g) {
    constexpr int d = 1 << (2 * P);
    AttnFrag f;
#pragma unroll
    for (int tl = 0; tl < 2; ++tl) {
        const int kb = 2 * pr + tl;
        int pos = r + d * (ub0 + 16 * kb + q); pos = pos < 0 ? 0 : (pos > TP - 1 ? TP - 1 : pos);
        const bf16_t* kp = Zk + (size_t)pos * NZ;
        f.k[tl][0] = *(const bf16x8s*)(kp); f.k[tl][1] = *(const bf16x8s*)(kp + 32);
        int u4 = ub0 + 16 * kb + 4 * g; u4 = u4 < 0 ? 0 : (u4 > TP / d - 4 ? TP / d - 4 : u4);
        const bf16_t* vp = VTp + r * (TP / d) + u4;
#pragma unroll
        for (int nb = 0; nb < 4; ++nb) f.v[nb][tl] = *(const u32x2*)(vp + (size_t)nb * 16 * TP);
    }
    return f;
}
template <int P>
__device__ __forceinline__ void attn_compute(const AttnFrag& f, const bf16x8s (&qf)[2], const LAS float* BLp, int jb, int jmax, int pr, f32x4 (&oacc)[4], float& m, float& l) {
    f32x4 sA = (f32x4){0.f, 0.f, 0.f, 0.f}, sB = (f32x4){0.f, 0.f, 0.f, 0.f};
    sA = __builtin_amdgcn_mfma_f32_16x16x32_bf16(f.k[0][0], qf[0], sA, 0, 0, 0); sA = __builtin_amdgcn_mfma_f32_16x16x32_bf16(f.k[0][1], qf[1], sA, 0, 0, 0);
    sB = __builtin_amdgcn_mfma_f32_16x16x32_bf16(f.k[1][0], qf[0], sB, 0, 0, 0); sB = __builtin_amdgcn_mfma_f32_16x16x32_bf16(f.k[1][1], qf[1], sB, 0, 0, 0);
    const int jA0 = jb - 32 * pr;
    bool vA[4], vB[4]; float mx = -1.0e30f;
#pragma unroll
    for (int e = 0; e < 4; ++e) {
        const int jA = jA0 - e, jB = jA0 - 16 - e;
        vA[e] = (unsigned)jA <= (unsigned)jmax; vB[e] = (unsigned)jB <= (unsigned)jmax;
        sA[e] = vA[e] ? sA[e] * 0.125f + BLp[jA] : -1.0e30f; sB[e] = vB[e] ? sB[e] * 0.125f + BLp[jB] : -1.0e30f;
        mx = fmaxf(mx, fmaxf(sA[e], sB[e]));
    }
    mx = fmaxf(mx, __shfl_xor(mx, 16)); mx = fmaxf(mx, __shfl_xor(mx, 32));
    const float mn = fmaxf(m, mx), alpha = __expf(m - mn);
    m = mn;
    float pA[4], pB[4], rs = 0.f;
#pragma unroll
    for (int e = 0; e < 4; ++e) { pA[e] = vA[e] ? __expf(sA[e] - mn) : 0.f; pB[e] = vB[e] ? __expf(sB[e] - mn) : 0.f; rs += pA[e] + pB[e]; }
    l = l * alpha + rs;
    union { bf16x8s v; unsigned u[4]; } pf;
    pf.u[0] = pk2(pA[0], pA[1]); pf.u[1] = pk2(pA[2], pA[3]); pf.u[2] = pk2(pB[0], pB[1]); pf.u[3] = pk2(pB[2], pB[3]);
#pragma unroll
    for (int nb = 0; nb < 4; ++nb) {
        union { bf16x8s v; unsigned u[4]; } vf; vf.u[0] = f.v[nb][0].x; vf.u[1] = f.v[nb][0].y; vf.u[2] = f.v[nb][1].x; vf.u[3] = f.v[nb][1].y;
        oacc[nb] = oacc[nb] * alpha;
        oacc[nb] = __builtin_amdgcn_mfma_f32_16x16x32_bf16(vf.v, pf.v, oacc[nb], 0, 0, 0);
    }
}
template <int P>
__device__ __forceinline__ void attn_pattern(const WsP& W, const bf16_t* VT, const LAS float* BL, int h, int t0, int rho, int q, int g, const bf16x8s (&qf)[2], f32x4 (&oacc)[4], float& m, float& l) {
    constexpr int d = 1 << (2 * P), a = 16 >> (2 * P), NP = (P == 0) ? 12 : ((P == 1) ? 6 : 5);
    const int r = rho & (d - 1), uq0 = (t0 + rho) >> (2 * P), ub0 = (uq0 - 128) & ~15, off = uq0 - 128 - ub0;
    const int uqi = uq0 + a * q, jmax = uqi < 128 ? uqi : 128, jb = a * q + off + 128 - 4 * g;
    const bf16_t* Zk = W.Z + C_BK + h * 64 + 8 * g;
    const bf16_t* VTp = VT + ((size_t)(P * 256 + h * 64 + q)) * TP;
    const LAS float* BLp = BL + P * 640 + 256;
    AttnFrag cur = attn_load<P>(Zk, VTp, ub0, r, 0, q, g);
#pragma unroll 1
    for (int pr = 0; pr < NP; ++pr) {
        const AttnFrag nxt = attn_load<P>(Zk, VTp, ub0, r, (pr + 1 < NP) ? pr + 1 : pr, q, g);
        attn_compute<P>(cur, qf, BLp, jb, jmax, pr, oacc, m, l);
        cur = nxt;
    }
}
__device__ __forceinline__ void attn_mfma_item(const LAS float* BL, const WsP& W, const bf16_t* VT, int h, int tb, int rho, int lane) {
    asm volatile("" : "+v"(lane));
    const int q = lane & 15, g = lane >> 4, t0 = tb * 256, tq = t0 + rho + 16 * q;
    bf16x8s qf[2];
    { const bf16_t* qp = W.Z + (size_t)tq * NZ + C_BQ + h * 64 + 8 * g; qf[0] = *(const bf16x8s*)qp; qf[1] = *(const bf16x8s*)(qp + 32); }
    f32x4 oacc[4];
#pragma unroll
    for (int nb = 0; nb < 4; ++nb) oacc[nb] = (f32x4){0.f, 0.f, 0.f, 0.f};
    float m = -1.0e30f, l = 0.f;
    attn_pattern<0>(W, VT, BL, h, t0, rho, q, g, qf, oacc, m, l);
    attn_pattern<1>(W, VT, BL, h, t0, rho, q, g, qf, oacc, m, l);
    attn_pattern<2>(W, VT, BL, h, t0, rho, q, g, qf, oacc, m, l);
    l += __shfl_xor(l, 16); l += __shfl_xor(l, 32);
    const float inv = 1.0f / l;
    bf16_t* yp = W.Y + (size_t)tq * DM + 256 + h * 64 + 4 * g;
#pragma unroll
    for (int nb = 0; nb < 4; ++nb) { u32x2 w; w.x = pk2(oacc[nb][0] * inv, oacc[nb][1] * inv); w.y = pk2(oacc[nb][2] * inv, oacc[nb][3] * inv); *(u32x2*)(yp + 16 * nb) = w; }
}
__device__ __forceinline__ void attn_sample_part(const LayerP& L, const WsP& W, float* PART, int si, int lane) {
    asm volatile("" : "+v"(lane));
    const int chunk = si & 7, bh = si >> 3, b = bh >> 2, h = bh & 3, sg = lane >> 4, dg = lane & 15;
    const size_t zrow = (size_t)(TP + b) * NZ;
    float q[4];
    { const u32x2 w = *(const u32x2*)(W.Z + zrow + C_BQ + h * 64 + dg * 4); q[0] = bflo(w.x); q[1] = bfhi(w.x); q[2] = bflo(w.y); q[3] = bfhi(w.y); }
    const float* ckb = L.ck + (size_t)b * 2048 * 256 + h * 64 + dg * 4; const float* cvb = L.cv + (size_t)b * 2048 * 256 + h * 64 + dg * 4;
    float lg[13]; float m = -3.0e38f;
#pragma unroll
    for (int i = 0; i < 13; ++i) {
        const int sl = i * 4 + sg, s = chunk * 49 + sl; const bool valid = (sl < 49) && (s < 387);
        const int p = (s >= 258) ? 2 : ((s >= 129) ? 1 : 0); const int jj = s - 129 * p; const int idx = 2048 - (jj << (2 * p));
        float d = 0.f;
        if (valid) {
            f32x4 kk;
            if (idx == 2048) { const u32x2 w = *(const u32x2*)(W.Z + zrow + C_BK + h * 64 + dg * 4); kk = (f32x4){bflo(w.x), bfhi(w.x), bflo(w.y), bfhi(w.y)}; }
            else kk = *(const f32x4*)(ckb + (size_t)idx * 256);
            d = (q[0] * kk.x + q[1] * kk.y) + (q[2] * kk.z + q[3] * kk.w);
        }
        d += __shfl_xor(d, 1); d += __shfl_xor(d, 2); d += __shfl_xor(d, 4); d += __shfl_xor(d, 8);
        lg[i] = valid ? d * 0.125f + W.BIAS[h * 388 + (valid ? s : 0)] : -1.0e30f;
        m = fmaxf(m, lg[i]);
    }
    m = fmaxf(m, __shfl_xor(m, 16)); m = fmaxf(m, __shfl_xor(m, 32));
    float o[4] = {0.f, 0.f, 0.f, 0.f}; float sum = 0.f;
#pragma unroll
    for (int i = 0; i < 13; ++i) {
        const int sl = i * 4 + sg, s = chunk * 49 + sl; const bool valid = (sl < 49) && (s < 387);
        const int p = (s >= 258) ? 2 : ((s >= 129) ? 1 : 0); const int jj = s - 129 * p; const int idx = 2048 - (jj << (2 * p));
        if (valid) {
            const float pr = __expf(lg[i] - m); sum += pr;
            f32x4 vv;
            if (idx == 2048) { const u32x2 w = *(const u32x2*)(W.Z + zrow + C_BV + h * 64 + dg * 4); vv = (f32x4){bflo(w.x), bfhi(w.x), bflo(w.y), bfhi(w.y)}; }
            else vv = *(const f32x4*)(cvb + (size_t)idx * 256);
            o[0] += pr * vv.x; o[1] += pr * vv.y; o[2] += pr * vv.z; o[3] += pr * vv.w;
        }
    }
    sum += __shfl_xor(sum, 16); sum += __shfl_xor(sum, 32);
#pragma unroll
    for (int e = 0; e < 4; ++e) { o[e] += __shfl_xor(o[e], 16); o[e] += __shfl_xor(o[e], 32); }
    float* pp = PART + (size_t)si * 72;
    if (sg == 0) *(f32x4*)(pp + dg * 4) = (f32x4){o[0], o[1], o[2], o[3]};
    if (lane == 0) { pp[64] = m; pp[65] = sum; }
}
__device__ __forceinline__ void attn_sample_combine(const WsP& W, const float* PART, int bh, int lane) {
    asm volatile("" : "+v"(lane));
    const float* pp = PART + (size_t)bh * 8 * 72;
    float mc[8], M = -3.0e38f;
#pragma unroll
    for (int c = 0; c < 8; ++c) { mc[c] = pp[c * 72 + 64]; M = fmaxf(M, mc[c]); }
    float S = 0.f, o = 0.f;
#pragma unroll
    for (int c = 0; c < 8; ++c) { const float f = __expf(mc[c] - M); S += pp[c * 72 + 65] * f; o += pp[c * 72 + lane] * f; }
    const int b = bh >> 2, h = bh & 3;
    W.Y[(size_t)(TP + b) * DM + 256 + h * 64 + lane] = (bf16_t)f2bf(o / S);
}

__device__ __forceinline__ void sample_mixers(LAS unsigned char* lds, int b, const LayerP& L, const WsP& W, float* out, int tid) {
    asm volatile("" : "+v"(tid));
    LAS float* US = (LAS float*)lds;
    LAS float* PS = US + 256;
    LAS float* EG = PS + 256;
    LAS float* QS = EG + 128;
    LAS float* KS = QS + 128;
    LAS float* VV = KS + 128;
    LAS float* OP = VV + 256;
    const int row = TP + b, lb = b;
    const bf16_t* zr = W.Z + (size_t)row * NZ;
    const int l = L.l;
    if (tid < 256) {
        const int ch = tid;
        const float h0 = L.slc[((size_t)lb * 3 + 0) * 256 + ch], h1 = L.slc[((size_t)lb * 3 + 1) * 256 + ch], h2 = L.slc[((size_t)lb * 3 + 2) * 256 + ch], a0 = bf2f(zr[C_AU + ch]);
        US[ch] = L.conv_b[ch] + L.conv_w[ch] * h0 + L.conv_w[256 + ch] * h1 + L.conv_w[512 + ch] * h2 + L.conv_w[768 + ch] * a0;
        float* o = out + O_SC + ((size_t)(l * NB + b) * 3) * 256 + ch; o[0] = h1; o[256] = h2; o[512] = a0;
        out[O_SK + (size_t)(l * NB + b) * 256 + ch] = bf2f(zr[C_BK + ch]);
        out[O_SV + (size_t)(l * NB + b) * 256 + ch] = bf2f(zr[C_BV + ch]);
    } else {
        const int ch = tid - 256, g = ch >> 6, w = 2 << g;
        const float* hp = L.spool + (size_t)lb * 15 * 256 + ch; const float cu = bf2f(zr[C_CU + ch]);
        float s = cu;
#pragma unroll 1
        for (int i = 1; i < w; ++i) s += hp[(15 - i) * 256];
        PS[ch] = s / (float)w - cu;
        float* o = out + O_SP + (size_t)(l * NB + b) * 15 * 256 + ch;
#pragma unroll 2
        for (int r = 0; r < 14; ++r) o[r * 256] = hp[(r + 1) * 256];
        o[14 * 256] = cu;
    }
    if (tid < 128) {
        const int n = tid; float a = L.gla_b[n]; const float* d = W.DLR + (size_t)row * 16;
#pragma unroll
        for (int jj = 0; jj < 16; ++jj) a += d[jj] * L.w_lr[jj * 128 + n];
        EG[n] = __expf(logsigmoidf_(a) * (1.0f / 16.0f)); QS[n] = bf2f(zr[C_DQ + n]) * 0.17677669529663687f; KS[n] = bf2f(zr[C_DK + n]);
    } else if (tid < 384) { VV[tid - 128] = bf2f(zr[C_DV + tid - 128]); }
    __syncthreads();
    if (tid < 256) {
        const int ch = tid, h = ch >> 6, j = ch & 63; float r = 0.f, gi = 0.f;
#pragma unroll 16
        for (int i = 0; i < 64; ++i) { const float uu = US[h * 64 + i]; r += uu * L.wa[h * 4096 + i * 64 + j]; gi += uu * L.wx[h * 4096 + i * 64 + j]; }
        const float rr = sigmoidf_(r + L.ba[ch]), gg = sigmoidf_(gi + L.bx[ch]), la = -8.0f * log1pf(__expf(-L.lam[ch])) * rr, a = __expf(la);
        const float hn = a * L.slh[(size_t)lb * 256 + ch] + sqrtf(-expm1f(2.0f * la)) * (gg * US[ch]);
        out[O_SH + (size_t)(l * NB + b) * 256 + ch] = hn;
        W.Y[(size_t)row * DM + ch] = (bf16_t)f2bf(hn * gelu_tanh(bf2f(zr[C_AG + ch])));
    } else {
        const int d = tid - 256, g = d >> 6; float a = 0.f;
#pragma unroll 16
        for (int c = 0; c < 64; ++c) a += PS[g * 64 + c] * L.pool_w[g * 4096 + c * 64 + (d & 63)];
        W.Y[(size_t)row * DM + 512 + d] = (bf16_t)f2bf(a * L.pool_s[d]);
    }
    {
        const int dv = tid & 63, wv = tid >> 6;
        float po[4] = {0.f, 0.f, 0.f, 0.f};
#pragma unroll
        for (int k = 0; k < 16; ++k) { const int idx = tid + NT * k, hh = idx >> 11, dk = (idx >> 6) & 31;
            const float s0 = L.sgla[(size_t)lb * 8192 + idx]; const float sn = EG[hh * 32 + dk] * s0 + KS[hh * 32 + dk] * VV[hh * 64 + dv];
            out[O_SG + (size_t)(l * NB + b) * 8192 + idx] = sn; po[k >> 2] += QS[hh * 32 + dk] * sn; }
#pragma unroll
        for (int hh = 0; hh < 4; ++hh) OP[wv * 256 + hh * 64 + dv] = po[hh];
    }
    __syncthreads();
    if (tid < 256) {
        float o = 0.f;
#pragma unroll
        for (int wv = 0; wv < 8; ++wv) o += OP[wv * 256 + tid];
        const float ss = wave_sum(o * o);
        const float y = o * rsqrtf(ss * (1.0f / 64.0f) + EPS) * L.gla_n[tid] * siluf_(bf2f(zr[C_DR + tid]));
        W.Y[(size_t)row * DM + 768 + tid] = (bf16_t)f2bf(y);
    }
    __syncthreads();
}

__device__ __forceinline__ void gla_scan_item(LAS unsigned char* lds, int it, const LayerP& L, const WsP& W, bf16_t* ST, float* out, int tid) {
    asm volatile("" : "+v"(tid));
    LAS float* SA = (LAS float*)lds; LAS float* SS = SA + 16;
    const int h = it >> 6, dk = (it >> 1) & 31, dv0 = (it & 1) * 32, cgp = tid >> 5, e = tid & 31;
    float d[16], s[16];
#pragma unroll
    for (int i = 0; i < 16; ++i) { const int c = cgp * 16 + i; d[i] = W.GDEC[c * 128 + h * 32 + dk]; s[i] = W.GDS[((size_t)(c * 4 + h) * 32 + dk) * 64 + dv0 + e]; }
    float A = 1.f, S = 0.f;
#pragma unroll
    for (int i = 0; i < 16; ++i) { S = d[i] * S + s[i]; A *= d[i]; }
    if (e == 0) SA[cgp] = A;
    SS[cgp * 32 + e] = S;
    __syncthreads();
    float Sin = 0.f;
    for (int jg = 0; jg < cgp; ++jg) Sin = SA[jg] * Sin + SS[jg * 32 + e];
    S = Sin;
#pragma unroll
    for (int i = 0; i < 16; ++i) { const int c = cgp * 16 + i; W.GDS[((size_t)(c * 4 + h) * 32 + dk) * 64 + dv0 + e] = S; ST[((size_t)(c * 4 + h) * 64 + dv0 + e) * 32 + dk] = (bf16_t)f2bf(S); S = d[i] * S + s[i]; }
    if (cgp == 15) out[O_PG + (size_t)L.l * 8192 + (h * 32 + dk) * 64 + dv0 + e] = S;
    __syncthreads();
}
__device__ __forceinline__ void lru_scan_item(LAS unsigned char* lds, int it, const LayerP& L, const WsP& W, float* out, int tid) {
    asm volatile("" : "+v"(tid));
    LAS float* LA_ = (LAS float*)lds; LAS float* LH_ = LA_ + 512;
    const int e = tid & 15, sg = tid >> 4, ch = it * 16 + e;
    float a[16], hh[16];
#pragma unroll
    for (int i = 0; i < 16; ++i) { const int seg = sg * 16 + i; a[i] = W.LA[seg * 256 + ch]; hh[i] = W.LH[seg * 256 + ch]; }
    float A = 1.f, H = 0.f;
#pragma unroll
    for (int i = 0; i < 16; ++i) { H = a[i] * H + hh[i]; A *= a[i]; }
    LA_[sg * 16 + e] = A; LH_[sg * 16 + e] = H;
    __syncthreads();
    float Hin = 0.f;
    for (int jg = 0; jg < sg; ++jg) Hin = LA_[jg * 16 + e] * Hin + LH_[jg * 16 + e];
    H = Hin;
#pragma unroll
    for (int i = 0; i < 16; ++i) { const int seg = sg * 16 + i; W.HIN[seg * 256 + ch] = H; H = a[i] * H + hh[i]; }
    if (sg == 31) out[O_PH + (size_t)L.l * 256 + ch] = H;
    __syncthreads();
}

__device__ __forceinline__ void lru_final(int tile, const LayerP& L, const WsP& W, int tid) {
    asm volatile("" : "+v"(tid));
    const int ch = tid & 255, half = tid >> 8, seg = tile * 2 + half, t0 = tile * 64 + half * 32;
    const float hin = W.HIN[seg * 256 + ch];
#pragma unroll 4
    for (int tok = 0; tok < 32; ++tok) { const size_t t = (size_t)(t0 + tok);
        const float hv = W.HLOC[t * 256 + ch] + W.PCUM[t * 256 + ch] * hin;
        W.Y[t * DM + ch] = (bf16_t)f2bf(hv * gelu_tanh(bf2f(W.Z[t * NZ + C_AG + ch]))); }
}
__device__ __forceinline__ bf16x8s gla_scaled_frag(const bf16_t* zp, const float* bp, float sgn, float scale) {
    const u32x4 w = *(const u32x4*)zp; const f32x4 b0 = *(const f32x4*)bp, b1 = *(const f32x4*)(bp + 4);
    float x[8]; x[0] = bflo(w.x); x[1] = bfhi(w.x); x[2] = bflo(w.y); x[3] = bfhi(w.y); x[4] = bflo(w.z); x[5] = bfhi(w.z); x[6] = bflo(w.w); x[7] = bfhi(w.w);
    float e[8]; e[0] = b0.x; e[1] = b0.y; e[2] = b0.z; e[3] = b0.w; e[4] = b1.x; e[5] = b1.y; e[6] = b1.z; e[7] = b1.w;
#pragma unroll
    for (int i = 0; i < 8; ++i) x[i] = x[i] * scale * __expf(sgn * e[i]);
    union { bf16x8s v; unsigned u[4]; } r; r.u[0] = pk2(x[0], x[1]); r.u[1] = pk2(x[2], x[3]); r.u[2] = pk2(x[4], x[5]); r.u[3] = pk2(x[6], x[7]);
    return r.v;
}
template <int IB>
__device__ __forceinline__ void gla_final_item(const LayerP& L, const WsP& W, const bf16_t* DVT, const bf16_t* ST, int c, int h, int lane) {
    const int q = lane & 15, g = lane >> 4;
    const size_t tq = (size_t)c * 64 + IB * 16 + q;
    const bf16x8s qb = gla_scaled_frag(W.Z + tq * NZ + C_DQ + h * 32 + 8 * g, W.GB + tq * 128 + h * 32 + 8 * g, 1.0f, 0.17677669529663687f);
    f32x4 att[IB + 1];
#pragma unroll
    for (int jb = 0; jb <= IB; ++jb) { const size_t tj = (size_t)c * 64 + jb * 16 + q;
        const bf16x8s kb = gla_scaled_frag(W.Z + tj * NZ + C_DK + h * 32 + 8 * g, W.GB + tj * 128 + h * 32 + 8 * g, -1.0f, 1.0f);
        att[jb] = __builtin_amdgcn_mfma_f32_16x16x32_bf16(kb, qb, (f32x4){0.f, 0.f, 0.f, 0.f}, 0, 0, 0); }
#pragma unroll
    for (int e = 0; e < 4; ++e) if (4 * g + e > q) att[IB][e] = 0.f;
    f32x4 o[4];
#pragma unroll
    for (int nb = 0; nb < 4; ++nb) { const bf16x8s sf = *(const bf16x8s*)(ST + ((size_t)(c * 4 + h) * 64 + 16 * nb + q) * 32 + 8 * g);
        o[nb] = __builtin_amdgcn_mfma_f32_16x16x32_bf16(sf, qb, (f32x4){0.f, 0.f, 0.f, 0.f}, 0, 0, 0); }
#pragma unroll
    for (int pr = 0; pr <= IB / 2; ++pr) {
        const int jA = 2 * pr, jB = 2 * pr + 1;
        union { bf16x8s v; unsigned u[4]; } pf;
        pf.u[0] = pk2(att[jA][0], att[jA][1]); pf.u[1] = pk2(att[jA][2], att[jA][3]);
        if (jB <= IB) { pf.u[2] = pk2(att[jB <= IB ? jB : 0][0], att[jB <= IB ? jB : 0][1]); pf.u[3] = pk2(att[jB <= IB ? jB : 0][2], att[jB <= IB ? jB : 0][3]); } else { pf.u[2] = 0u; pf.u[3] = 0u; }
#pragma unroll
        for (int nb = 0; nb < 4; ++nb) { const bf16_t* vp = DVT + (size_t)(h * 64 + 16 * nb + q) * TP + c * 64 + 4 * g;
            union { bf16x8s v; unsigned u[4]; } vf; const u32x2 va = *(const u32x2*)(vp + 16 * jA); vf.u[0] = va.x; vf.u[1] = va.y;
            if (jB <= IB) { const u32x2 vb = *(const u32x2*)(vp + 16 * jB); vf.u[2] = vb.x; vf.u[3] = vb.y; } else { vf.u[2] = 0u; vf.u[3] = 0u; }
            o[nb] = __builtin_amdgcn_mfma_f32_16x16x32_bf16(vf.v, pf.v, o[nb], 0, 0, 0); }
    }
    float ss = 0.f;
#pragma unroll
    for (int nb = 0; nb < 4; ++nb) ss += (o[nb][0] * o[nb][0] + o[nb][1] * o[nb][1]) + (o[nb][2] * o[nb][2] + o[nb][3] * o[nb][3]);
    ss += __shfl_xor(ss, 16); ss += __shfl_xor(ss, 32);
    const float rstd = rsqrtf(ss * (1.0f / 64.0f) + EPS);
#pragma unroll
    for (int nb = 0; nb < 4; ++nb) { const int dim = h * 64 + 16 * nb + 4 * g;
        const u32x2 dr = *(const u32x2*)(W.Z + tq * NZ + C_DR + dim); const f32x4 gn = *(const f32x4*)(L.gla_n + dim);
        const float y0 = o[nb][0] * rstd * gn.x * siluf_(bflo(dr.x)), y1 = o[nb][1] * rstd * gn.y * siluf_(bfhi(dr.x)), y2 = o[nb][2] * rstd * gn.z * siluf_(bflo(dr.y)), y3 = o[nb][3] * rstd * gn.w * siluf_(bfhi(dr.y));
        u32x2 w; w.x = pk2(y0, y1); w.y = pk2(y2, y3); *(u32x2*)(W.Y + tq * DM + 768 + dim) = w; }
}
__device__ __forceinline__ void gla_final_wave(const LayerP& L, const WsP& W, const bf16_t* DVT, const bf16_t* ST, int wi, int lane) {
    asm volatile("" : "+v"(lane));
    const int ib = wi & 3, h = (wi >> 2) & 3, c = wi >> 4;
    if (ib == 0) gla_final_item<0>(L, W, DVT, ST, c, h, lane);
    else if (ib == 1) gla_final_item<1>(L, W, DVT, ST, c, h, lane);
    else if (ib == 2) gla_final_item<2>(L, W, DVT, ST, c, h, lane);
    else gla_final_item<3>(L, W, DVT, ST, c, h, lane);
}

typedef float f32x16 __attribute__((ext_vector_type(16)));
template <int MODE, int K>
__device__ __forceinline__ void skinny_unit(LAS unsigned char* lds, const bf16_t* A, const bf16_t* Bt, int n0, void* O, int ldo, const float* rscale, int tid) {
    asm volatile("" : "+v"(tid));
    const int lane = tid & 63, wave = tid >> 6, r = lane & 31, hh = lane >> 5;
    constexpr int KW = K / 8, STEPS = KW / 16;
    const bf16_t* ap = A + (size_t)(TP + r) * K + wave * KW + 8 * hh;
    const bf16_t* bp = Bt + (size_t)(n0 + r) * K + wave * KW + 8 * hh;
    f32x16 acc;
#pragma unroll
    for (int e = 0; e < 16; ++e) acc[e] = 0.f;
#pragma unroll 8
    for (int st = 0; st < STEPS; ++st) { const bf16x8s a = *(const bf16x8s*)(ap + st * 16); const bf16x8s b = *(const bf16x8s*)(bp + st * 16); acc = __builtin_amdgcn_mfma_f32_32x32x16_bf16(a, b, acc, 0, 0, 0); }
    LAS float* RED = (LAS float*)lds;
#pragma unroll
    for (int e = 0; e < 16; ++e) RED[(wave * 16 + e) * 64 + lane] = acc[e];
    __syncthreads();
#pragma unroll
    for (int k = 0; k < 2; ++k) { const int reg = wave * 2 + k; float v = 0.f;
#pragma unroll
        for (int w = 0; w < 8; ++w) v += RED[(w * 16 + reg) * 64 + lane];
        const int row = TP + (reg & 3) + 8 * (reg >> 2) + 4 * hh, col = n0 + r;
        if (MODE == 2) ((float*)O)[(size_t)row * ldo + col] = v;
        else { float x = v * rscale[row]; if (MODE == 1) { x = fmaxf(x, 0.f); x = x * x; } ((bf16_t*)O)[(size_t)row * ldo + col] = (bf16_t)f2bf(x); } }
    __syncthreads();
}

typedef int PtrTab;
template <int BYTE_OFF> __device__ __forceinline__ unsigned long long karg_ld() {
    unsigned long long v;
    auto kp = __builtin_amdgcn_kernarg_segment_ptr();
    asm volatile("s_load_dwordx2 %0, %1, %2\n\ts_waitcnt lgkmcnt(0)" : "=s"(v) : "s"(kp), "i"(BYTE_OFF));
    return v;
}
#define pt_ld(PT, i) karg_ld<8 * (i)>()
#define IN_(i) ((const float*)pt_ld(PT, (i)))
#define FRESH_IDS() int tid = threadIdx.x; asm volatile("" : "+v"(tid)); const int lane = tid & 63; const int wave = __builtin_amdgcn_readfirstlane(tid >> 6); const int gw = bid * NWAVES + wave, NGW = G * NWAVES; (void)lane; (void)gw; (void)NGW; \
    unsigned char* ws = (unsigned char*)pt_ld(PT, 30); float* out = (float*)pt_ld(PT, 29); (void)out
__device__ __forceinline__ WsP make_w(unsigned char* ws) {
    WsP W;
    W.XB = (bf16_t*)(ws + WS_XB); W.Z = (bf16_t*)(ws + WS_Z); W.Y = (bf16_t*)(ws + WS_Y); W.U = (bf16_t*)(ws + WS_U); W.MIX = (float*)(ws + WS_MIX);
    W.RSTD = (float*)(ws + WS_RSTD); W.DLR = (float*)(ws + WS_DLR); W.HLOC = (float*)(ws + WS_HLOC); W.PCUM = (float*)(ws + WS_PCUM);
    W.LA = (float*)(ws + WS_LAGG); W.LH = W.LA + 512 * 256; W.HIN = W.LH + 512 * 256;
    W.GDS = (float*)(ws + WS_GDS); W.GDEC = (float*)(ws + WS_GDEC); W.GB = (float*)(ws + WS_GB); W.BIAS = (float*)(ws + WS_BIAS);
    return W;
}
__device__ __forceinline__ LayerP make_l(PtrTab PT, int l) {
    LayerP L;
    L.l = l;
    L.conv_w = IN_(I_CONVW) + l * 1024; L.conv_b = IN_(I_CONVB) + l * 256; L.wa = IN_(I_WA) + l * 16384; L.ba = IN_(I_BA) + l * 256;
    L.wx = IN_(I_WX) + l * 16384; L.bx = IN_(I_BX) + l * 256; L.lam = IN_(I_LAM) + l * 256; L.pool_w = IN_(I_POOLW) + l * 16384; L.pool_s = IN_(I_POOLS) + l * 256;
    L.w_lr = IN_(I_WLR) + l * 2048; L.gla_b = IN_(I_GLAB) + l * 128; L.gla_n = IN_(I_GLAN) + l * 256;
    L.slh = IN_(I_SLH) + (size_t)l * NB * 256; L.slc = IN_(I_SLC) + (size_t)l * NB * 768; L.ck = IN_(I_CK) + (size_t)l * NB * 2048 * 256; L.cv = IN_(I_CV) + (size_t)l * NB * 2048 * 256;
    L.spool = IN_(I_SPOOL) + (size_t)l * NB * 3840; L.sgla = IN_(I_SGLA) + (size_t)l * NB * 8192;
    return L;
}

#ifndef REP_LRUL
#define REP_LRUL 1
#endif
#ifndef REP_GLAL
#define REP_GLAL 1
#endif
#ifndef REP_POOL
#define REP_POOL 1
#endif
#ifndef REP_VTR
#define REP_VTR 1
#endif
#ifndef REP_LRUF
#define REP_LRUF 1
#endif
#ifndef REP_GLAF
#define REP_GLAF 1
#endif
#ifndef REP_M1T
#define REP_M1T 1
#endif
#ifndef REP_ATT
#define REP_ATT 1
#endif
#ifndef REP_M3T
#define REP_M3T 1
#endif
#ifndef REP_G3
#define REP_G3 1
#endif
template <int l>
__device__ __forceinline__ void layer_body(LAS unsigned char* lds, const XcdBarrier& bar, const int G, const int bid) {
    const PtrTab PT = 0; (void)PT;
        {
            FRESH_IDS(); const WsP W = make_w(ws);
            pg8::Gemm g{W.XB, (const bf16_t*)(ws + WS_WIN) + (size_t)l * NZ * DM, TP, NZ, DM}; pg8::StaticOrder S; S.init(TP, NZ, G, bid);
            pg8::EpiScaleBf16<0> E{W.Z, NZ, W.RSTD};
            for (int u = bid; u < NZ / 32; u += G) skinny_unit<0, DM>(lds, W.XB, (const bf16_t*)(ws + WS_WIN) + (size_t)l * NZ * DM, u * 32, W.Z, NZ, W.RSTD, tid);
#ifndef SK_GEMM
            pg8::gemm_phase<pg8::EpiScaleBf16<0>, pg8::StaticOrder, true, true>(lds, g, S, E);
#endif
        }
        xcd_barrier(bar);

        {
            FRESH_IDS(); const WsP W = make_w(ws); const LayerP L = make_l(PT, l);
            for (int rep_ = 0; rep_ < REP_M1T; ++rep_)
            for (int tile = bid; tile < 256; tile += G) {
#ifndef SK_LRUL
                for (int r2_ = 0; r2_ < REP_LRUL; ++r2_) lru_local(lds, tile, L, W, out, tid);
#endif
#ifndef SK_GLAL
                for (int r2_ = 0; r2_ < REP_GLAL; ++r2_) gla_local(lds, tile, L, W, tid);
#endif
#ifndef SK_POOL
                for (int r2_ = 0; r2_ < REP_POOL; ++r2_) pool_tile(lds, tile, L, W, out, tid);
#endif
                for (int r2_ = 0; r2_ < REP_VTR; ++r2_) { vt_repack<C_BV, 3>(lds, tile, W, (bf16_t*)(ws + WS_VT), tid); vt_repack<C_DV, 1>(lds, tile, W, (bf16_t*)(ws + WS_DVT), tid); }
 }
#ifndef SK_SAMP
            for (int b = bid; b < NB; b += G) sample_mixers(lds, b, L, W, out, tid);
#endif
            for (int si = gw; si < NB * 4 * 8; si += NGW) attn_sample_part(L, W, (float*)(ws + WS_PART), si, lane);
            for (int i = bid * NT + tid; i < 2 * 2048 * 256; i += G * NT) { const int which = i >> 19, r = (i >> 8) & 2047, c = i & 255;
                out[(which ? O_PV : O_PK) + (size_t)l * 524288 + r * 256 + c] = bf2f(W.Z[(size_t)(TP - 2048 + r) * NZ + (which ? C_BV : C_BK) + c]); }
        }
        xcd_barrier(bar);

        {
            FRESH_IDS(); const WsP W = make_w(ws); LayerP L; L.l = l;
#ifndef SK_SCAN
            for (int it = bid; it < 272; it += G) { if (it < 256) gla_scan_item(lds, it, L, W, (bf16_t*)(ws + WS_ST), out, tid); else lru_scan_item(lds, it - 256, L, W, out, tid); }
#endif
        }
        xcd_barrier(bar);

        {
            FRESH_IDS(); const WsP W = make_w(ws); const LayerP L = make_l(PT, l);
            for (int bh = gw; bh < NB * 4; bh += NGW) attn_sample_combine(W, (const float*)(ws + WS_PART), bh, lane);
#ifndef SK_ATTN
            for (int rep_ = 0; rep_ < REP_ATT; ++rep_)
            for (int wi0 = bid * NWAVES; wi0 < 64 * 4 * 16; wi0 += NGW) {
                const int unit = wi0 >> 4, hh = unit & 3, tb = unit >> 2;
                LAS float* BL = (LAS float*)lds;
                for (int i = tid; i < 3 * 640; i += NT) { const int p = i / 640, j = i % 640 - 256; BL[i] = (j >= 0 && j <= 128) ? W.BIAS[hh * 388 + 129 * p + j] : 0.f; }
                __syncthreads();
                attn_mfma_item(BL, W, (const bf16_t*)(ws + WS_VT), hh, tb, (wi0 + wave) & 15, lane);
                __syncthreads();
            }
#endif
#ifndef SK_GLAF
            for (int r2_ = 0; r2_ < REP_GLAF; ++r2_) for (int wi = gw; wi < 256 * 16; wi += NGW) gla_final_wave(L, W, (const bf16_t*)(ws + WS_DVT), (const bf16_t*)(ws + WS_ST), wi, lane);
#endif
            for (int rep_ = 0; rep_ < REP_M3T; ++rep_)
            for (int tile = bid; tile < 256; tile += G) {
#ifndef SK_LRUF
                for (int r2_ = 0; r2_ < REP_LRUF; ++r2_) lru_final(tile, L, W, tid);
#endif
 }
        }
        xcd_barrier(bar);

        {
            FRESH_IDS(); const WsP W = make_w(ws);
            pg8::Gemm g{W.Y, (const bf16_t*)(ws + WS_WOUT) + (size_t)l * DM * DM, TP, DM, DM}; pg8::StaticOrder S; S.init(TP, DM, G, bid);
            for (int u = bid; u < DM / 32; u += G) skinny_unit<2, DM>(lds, W.Y, (const bf16_t*)(ws + WS_WOUT) + (size_t)l * DM * DM, u * 32, W.MIX, DM, nullptr, tid);
            pg8::EpiF32 E{W.MIX, DM};
#ifndef SK_GEMM
            pg8::gemm_phase<pg8::EpiF32, pg8::StaticOrder, true, true>(lds, g, S, E);
#endif
        }
        xcd_barrier(bar);
        {
            FRESH_IDS(); const WsP W = make_w(ws);
            rowpass<true, false>(lds, l == 0 ? IN_(I_XP) : out + O_YP, l == 0 ? IN_(I_XS) : out + O_YS, out, W.MIX, IN_(I_NPOSTMIX) + l * DM, nullptr, nullptr, W.XB, W.RSTD, W.DLR, gw, NGW, tid);
        }
        xcd_barrier(bar);
        {
            FRESH_IDS(); const WsP W = make_w(ws);
            pg8::Gemm g{W.XB, (const bf16_t*)(ws + WS_WUP) + (size_t)l * FF * DM, TP, FF, DM}; pg8::StaticOrder S; S.init(TP, FF, G, bid);
            pg8::EpiScaleBf16<1> E{W.U, FF, W.RSTD};
            for (int u = bid; u < FF / 32; u += G) skinny_unit<1, DM>(lds, W.XB, (const bf16_t*)(ws + WS_WUP) + (size_t)l * FF * DM, u * 32, W.U, FF, W.RSTD, tid);
#ifndef SK_GEMM
            for (int rep_ = 0; rep_ < REP_G3; ++rep_)
            pg8::gemm_phase<pg8::EpiScaleBf16<1>, pg8::StaticOrder, true, true>(lds, g, S, E);
#endif
        }
        xcd_barrier(bar);
        {
            FRESH_IDS(); const WsP W = make_w(ws);
            pg8::Gemm g{W.U, (const bf16_t*)(ws + WS_WDN) + (size_t)l * DM * FF, TP, DM, FF}; pg8::StaticOrder S; S.init(TP, DM, G, bid);
            for (int u = bid; u < DM / 32; u += G) skinny_unit<2, FF>(lds, W.U, (const bf16_t*)(ws + WS_WDN) + (size_t)l * DM * FF, u * 32, W.MIX, DM, nullptr, tid);
            pg8::EpiF32 E{W.MIX, DM};
#ifndef SK_GEMM
            pg8::gemm_phase<pg8::EpiF32, pg8::StaticOrder, true, true>(lds, g, S, E);
#endif
        }
        xcd_barrier(bar);
        {
            FRESH_IDS(); const WsP W = make_w(ws);
#ifndef SK_ROWP
            if (l == 0) rowpass<true, true>(lds, out + O_YP, out + O_YS, out, W.MIX, IN_(I_NPOSTMLP) + l * DM, IN_(I_NPREMIX) + DM, IN_(I_WIN) + (size_t)DM * NIN, W.XB, W.RSTD, W.DLR, gw, NGW, tid);
            else        rowpass<true, false>(lds, out + O_YP, out + O_YS, out, W.MIX, IN_(I_NPOSTMLP) + l * DM, nullptr, nullptr, W.XB, W.RSTD, W.DLR, gw, NGW, tid);
#endif
        }
        if (l == 0) xcd_barrier(bar);

}

__global__ void __launch_bounds__(NT, 2) mk_fwd(Args args) {
    extern __shared__ __attribute__((aligned(16))) unsigned char lds_raw[];
    LAS unsigned char* lds = (LAS unsigned char*)lds_raw;
    cg::grid_group grid = cg::this_grid();
    const int G = gridDim.x, bid = blockIdx.x;
    volatile LAS unsigned* MISC = (volatile LAS unsigned*)(lds + MISC_OFF);
    const PtrTab PT = 0; (void)PT;
    if (threadIdx.x < 32) MISC[threadIdx.x] = 0u;
    __syncthreads();
    XcdBarrier bar = xcd_barrier_post((unsigned*)(args.ws + WS_CTL) + CW_BAR, MISC + 8);

    {
        FRESH_IDS(); const WsP W = make_w(ws);
        LAS float* scr = (LAS float*)(lds + wave * 16384);
        constexpr int I_IN = 16 * (NZ / 32), I_OUT = 16 * 32, I_UP = 16 * (FF / 32), I_DN = 64 * 32, I_L = I_IN + I_OUT + I_UP + I_DN;
        for (int it = gw; it < 2 * I_L; it += NGW) {
            const int l = it / I_L; int r = it % I_L;
            if (r < I_IN) { p0_transpose_item(IN_(I_WIN) + (size_t)l * DM * NIN, NIN, DM, NZ, IN_(I_NPREMIX) + l * DM, (bf16_t*)(ws + WS_WIN) + (size_t)l * NZ * DM, scr, r, lane); continue; } r -= I_IN;
            if (r < I_OUT) { p0_transpose_item(IN_(I_WOUT) + (size_t)l * DM * DM, DM, DM, DM, nullptr, (bf16_t*)(ws + WS_WOUT) + (size_t)l * DM * DM, scr, r, lane); continue; } r -= I_OUT;
            if (r < I_UP) { p0_transpose_item(IN_(I_WUP) + (size_t)l * DM * FF, FF, DM, FF, IN_(I_NPREMLP) + l * DM, (bf16_t*)(ws + WS_WUP) + (size_t)l * FF * DM, scr, r, lane); continue; } r -= I_UP;
            p0_transpose_item(IN_(I_WDOWN) + (size_t)l * FF * DM, DM, FF, DM, nullptr, (bf16_t*)(ws + WS_WDN) + (size_t)l * DM * FF, scr, r, lane);
        }
        { const float* relb = IN_(I_RELB); for (int i = bid * NT + tid; i < 4 * 388; i += G * NT) { const int h = i / 388, s = i % 388; W.BIAS[i] = (s < 387) ? relb[BUCKET[s] * 4 + h] : 0.f; } }
        __syncthreads();
        rowpass<false, true>(lds, IN_(I_XP), IN_(I_XS), nullptr, nullptr, nullptr, IN_(I_NPREMIX), IN_(I_WIN), W.XB, W.RSTD, W.DLR, gw, NGW, tid);
    }
    xcd_barrier(bar);

    layer_body<0>(lds, bar, G, bid);
    layer_body<1>(lds, bar, G, bid);
    if (G == 0x7fffffff) grid.sync();
}

extern "C" void kernel_launch(void* const* d_in, const int* in_sizes, int n_in, void* d_out, int out_size, void* d_ws, size_t ws_size, hipStream_t stream) {
    static int grid = 0;
    if (grid == 0) {
        if (n_in != N_INPUTS || out_size != (int)O_END || ws_size < WS_END) { fprintf(stderr, "kernel_launch: unexpected sizes: n_in %d out %d ws %zu\n", n_in, out_size, ws_size); grid = -1; return; }
        int dev = 0, cus = 0, per_cu = 0;
        if (hipGetDevice(&dev) != hipSuccess || hipDeviceGetAttribute(&cus, hipDeviceAttributeMultiprocessorCount, dev) != hipSuccess) { grid = -1; return; }
        if (hipFuncSetAttribute((const void*)mk_fwd, hipFuncAttributeMaxDynamicSharedMemorySize, LDS_BYTES) != hipSuccess) { fprintf(stderr, "kernel_launch: hipFuncSetAttribute failed\n"); grid = -1; return; }
        if (hipOccupancyMaxActiveBlocksPerMultiprocessor(&per_cu, (const void*)mk_fwd, NT, LDS_BYTES) != hipSuccess || per_cu < 1) { fprintf(stderr, "kernel_launch: occupancy query says %d blocks per CU\n", per_cu); grid = -1; return; }
        grid = cus;
    }
    if (grid < 0) return;
    (void)hipMemsetAsync((char*)d_ws + WS_CTL, 0, CTL_ZERO_BYTES, stream);
    Args a{};
    for (int i = 0; i < N_INPUTS; ++i) a.in[i] = (const float*)d_in[i];
    a.out = (float*)d_out; a.ws = (unsigned char*)d_ws;
    void* kargs[] = {&a};
    hipError_t e = hipLaunchCooperativeKernel((const void*)mk_fwd, dim3(grid), dim3(NT), kargs, LDS_BYTES, stream);
    if (e != hipSuccess) fprintf(stderr, "cooperative launch failed: %s (grid %d)\n", hipGetErrorString(e), grid);
}
```
